# Optimizing an MI355X kernel written in HIP

```python
import math
import jax, jax.numpy as jnp
from jax import lax
import numpy as np

D_MODEL = 1024
BATCH = 2
SEQ = 8192
DEPTH = 1

CHUNK = 64
D_MIX = D_MODEL
SB_HEADS = 8
SB_HEAD_DIM = 64
SB_WIDTH = SB_HEADS * SB_HEAD_DIM
LRU_WIDTH = D_MIX - SB_WIDTH
LRU_BLOCKS = 8
LRU_BLOCK_W = LRU_WIDTH // LRU_BLOCKS
CONV_W = 4
RG_C = 8.0
Q_BLOCK = 128
N_GROUPS = 4
EXPERTS_PER_GROUP = 8
N_EXPERTS = N_GROUPS * EXPERTS_PER_GROUP
TOP_K_FINE = 2
D_EXPERT = 512
EPS = 1e-6
IN_COLS = 3 * SB_WIDTH + 2 * LRU_WIDTH

kernel_name = "hymba_stickbreak_rglru_hiermoe"


def _rms(x, g):
    xf = x.astype(jnp.float32)
    y = xf * lax.rsqrt(jnp.mean(xf * xf, axis=-1, keepdims=True) + EPS)
    return (y * g.astype(jnp.float32)).astype(x.dtype)


def _stick_breaking(q, k, v):
    b, h, s, d = q.shape
    nb = s // Q_BLOCK
    scale = 1.0 / math.sqrt(d)
    qb = q.reshape(b, h, nb, Q_BLOCK, d).transpose(2, 0, 1, 3, 4)
    key_pos = jnp.arange(s)

    def one_block(args):
        q_blk, blk = args
        t_pos = blk * Q_BLOCK + jnp.arange(Q_BLOCK)
        mask = key_pos[None, :] < t_pos[:, None]
        z = jnp.einsum('bhqd,bhkd->bhqk', q_blk, k).astype(jnp.float32) * scale
        log_nb_raw = jax.nn.log_sigmoid(-z)
        log_b = z + log_nb_raw
        log_nb = jnp.where(mask, log_nb_raw, 0.0)
        excl = lax.cumsum(log_nb, axis=3, reverse=True) - log_nb
        a = jnp.where(mask, jnp.exp(log_b + excl), 0.0)
        return jnp.einsum('bhqk,bhkd->bhqd', a.astype(v.dtype), v)

    out = lax.map(one_block, (qb, jnp.arange(nb)))
    return out.transpose(1, 0, 3, 2, 4).reshape(b, s, h * d)


def _causal_dwconv(x, w, bias):
    c = x.shape[-1]
    y = lax.conv_general_dilated(
        x, w.reshape(CONV_W, 1, c).astype(x.dtype), window_strides=(1,),
        padding=[(CONV_W - 1, 0)], dimension_numbers=('NWC', 'WIO', 'NWC'),
        feature_group_count=c)
    return y + bias


def _rglru(xc, w_rgate, b_rgate, w_igate, b_igate, lam):
    b, s, c = xc.shape
    xb = xc.reshape(b, s, LRU_BLOCKS, LRU_BLOCK_W)
    r = jax.nn.sigmoid(jnp.einsum('bsnc,ncd->bsnd', xb, w_rgate).reshape(b, s, c) + b_rgate)
    i = jax.nn.sigmoid(jnp.einsum('bsnc,ncd->bsnd', xb, w_igate).reshape(b, s, c) + b_igate)
    log_a = RG_C * r.astype(jnp.float32) * jax.nn.log_sigmoid(lam.astype(jnp.float32))
    a = jnp.exp(log_a)
    mult = jnp.sqrt(-jnp.expm1(2.0 * log_a))
    u = mult * (i * xc).astype(jnp.float32)

    def combine(left, right):
        a1, b1 = left
        a2, b2 = right
        return a1 * a2, a2 * b1 + b2

    _, hseq = lax.associative_scan(combine, (a, u), axis=1)
    return hseq.astype(xc.dtype)


def _hier_moe(u, w_group, b_group, w_fine, b_fine, w_e_gate, w_e_up, w_e_down):
    b, s, d = u.shape
    n = b * s
    xt = u.reshape(n, d)
    g_logits = (xt @ w_group + b_group).astype(jnp.float32)
    g_probs = jax.nn.softmax(g_logits, axis=-1)
    g_idx = jnp.argmax(g_probs, axis=-1)
    g_p = jnp.take_along_axis(g_probs, g_idx[:, None], axis=-1)
    f_logits = (xt @ w_fine + b_fine).astype(jnp.float32).reshape(n, N_GROUPS, EXPERTS_PER_GROUP)
    f_logits = jnp.take_along_axis(f_logits, g_idx[:, None, None], axis=1)[:, 0]
    f_probs = jax.nn.softmax(f_logits, axis=-1)
    top_p, top_i = lax.top_k(f_probs, TOP_K_FINE)
    top_p = top_p / jnp.sum(top_p, axis=-1, keepdims=True)
    weights = (g_p * top_p).reshape(-1)
    expert_ids = (g_idx[:, None] * EXPERTS_PER_GROUP + top_i).reshape(-1).astype(jnp.int32)
    order = jnp.argsort(expert_ids)
    tok = order // TOP_K_FINE
    xs = xt[tok]
    sizes = jnp.bincount(expert_ids, length=N_EXPERTS).astype(jnp.int32)
    hg = lax.ragged_dot(xs, w_e_gate, sizes)
    hu = lax.ragged_dot(xs, w_e_up, sizes)
    ys = lax.ragged_dot(jax.nn.silu(hg) * hu, w_e_down, sizes)
    ys = ys * weights[order][:, None].astype(ys.dtype)
    out = jnp.zeros((n, d), ys.dtype).at[tok].add(ys)
    return out.reshape(b, s, d).astype(u.dtype)


def setup_inputs(seed: int = 0) -> dict:
    key = jax.random.key(seed)
    ks = jax.random.split(key, 24)
    f32 = jnp.float32
    nrm = lambda k, shp, fan: jax.random.normal(k, shp, f32) * (fan ** -0.5)
    u_dec = jax.random.uniform(ks[10], (LRU_WIDTH,), f32, 0.9, 0.999)
    a0 = u_dec ** (1.0 / RG_C)
    lam = jnp.log(a0) - jnp.log1p(-a0)
    return {
        "x": jax.random.normal(ks[0], (BATCH, SEQ, D_MODEL), f32),
        "norm1_g": 1.0 + 0.05 * jax.random.normal(ks[1], (D_MODEL,), f32),
        "w_in": nrm(ks[2], (D_MODEL, IN_COLS), D_MODEL),
        "conv_w": nrm(ks[3], (CONV_W, LRU_WIDTH), CONV_W),
        "conv_b": 0.02 * jax.random.normal(ks[4], (LRU_WIDTH,), f32),
        "w_rgate": nrm(ks[5], (LRU_BLOCKS, LRU_BLOCK_W, LRU_BLOCK_W), LRU_BLOCK_W),
        "b_rgate": 0.02 * jax.random.normal(ks[6], (LRU_WIDTH,), f32),
        "w_igate": nrm(ks[7], (LRU_BLOCKS, LRU_BLOCK_W, LRU_BLOCK_W), LRU_BLOCK_W),
        "b_igate": 0.02 * jax.random.normal(ks[8], (LRU_WIDTH,), f32),
        "lam": lam,
        "sb_norm_g": 1.0 + 0.05 * jax.random.normal(ks[9], (SB_WIDTH,), f32),
        "lru_norm_g": 1.0 + 0.05 * jax.random.normal(ks[11], (LRU_WIDTH,), f32),
        "w_out": nrm(ks[12], (D_MIX, D_MODEL), D_MIX),
        "norm2_g": 1.0 + 0.05 * jax.random.normal(ks[13], (D_MODEL,), f32),
        "w_group": nrm(ks[14], (D_MODEL, N_GROUPS), D_MODEL),
        "b_group": 0.01 * jax.random.normal(ks[15], (N_GROUPS,), f32),
        "w_fine": nrm(ks[16], (D_MODEL, N_EXPERTS), D_MODEL),
        "b_fine": 0.01 * jax.random.normal(ks[17], (N_EXPERTS,), f32),
        "w_e_gate": nrm(ks[18], (N_EXPERTS, D_MODEL, D_EXPERT), D_MODEL),
        "w_e_up": nrm(ks[19], (N_EXPERTS, D_MODEL, D_EXPERT), D_MODEL),
        "w_e_down": nrm(ks[20], (N_EXPERTS, D_EXPERT, D_MODEL), D_EXPERT),
        "final_g": 1.0 + 0.05 * jax.random.normal(ks[21], (D_MODEL,), f32),
    }


def reference(x, norm1_g, w_in, conv_w, conv_b, w_rgate, b_rgate, w_igate, b_igate, lam,
              sb_norm_g, lru_norm_g, w_out, norm2_g, w_group, b_group, w_fine, b_fine,
              w_e_gate, w_e_up, w_e_down, final_g):
    b, s, _ = x.shape
    h = x
    for _layer in range(DEPTH):
        u = _rms(h, norm1_g)
        proj = u @ w_in
        q, k, v, x_lru, g_lru = jnp.split(
            proj, [SB_WIDTH, 2 * SB_WIDTH, 3 * SB_WIDTH, 3 * SB_WIDTH + LRU_WIDTH], axis=-1)
        to_heads = lambda t: t.reshape(b, s, SB_HEADS, SB_HEAD_DIM).transpose(0, 2, 1, 3)
        out_sb = _stick_breaking(to_heads(q), to_heads(k), to_heads(v))
        xc = _causal_dwconv(x_lru, conv_w, conv_b)
        out_lru = _rglru(xc, w_rgate, b_rgate, w_igate, b_igate, lam) * jax.nn.gelu(g_lru, approximate=True)
        mixed = jnp.concatenate([_rms(out_sb, sb_norm_g), _rms(out_lru, lru_norm_g)], axis=-1)
        h = h + mixed @ w_out
        h = h + _hier_moe(_rms(h, norm2_g), w_group, b_group, w_fine, b_fine,
                          w_e_gate, w_e_up, w_e_down)
    return _rms(h, final_g)
```

```cpp
#include <hip/hip_runtime.h>
#include <cstdio>
#include <cstdint>
namespace nv {
constexpr int NB = 2, NS = 8192, ND = 1024, NM = NB * NS, NIN = 2560, NHW = 512, NE = 32, NDE = 512;
constexpr float NEPS = 1e-6f;

__device__ __forceinline__ float wsum(float v) {
#pragma unroll
    for (int o = 1; o < 64; o <<= 1) v += __shfl_xor(v, o);
    return v;
}
template <int PER>
__global__ void k_rms(const float* in, int in_pitch, const float* g, float* out, int out_pitch, int rows) {
    const int gw = (blockIdx.x * blockDim.x + threadIdx.x) >> 6, lane = threadIdx.x & 63, nw = (gridDim.x * blockDim.x) >> 6;
    for (int r = gw; r < rows; r += nw) {
        const float* p = in + (size_t)r * in_pitch; float v[PER]; float s = 0.f;
#pragma unroll
        for (int j = 0; j < PER; ++j) { v[j] = p[lane + 64 * j]; s += v[j] * v[j]; }
        s = wsum(s); const float ri = 1.0f / sqrtf(s * (1.0f / (64 * PER)) + NEPS);
        float* o = out + (size_t)r * out_pitch;
#pragma unroll
        for (int j = 0; j < PER; ++j) o[lane + 64 * j] = v[j] * ri * g[lane + 64 * j];
    }
}
struct SgP { const float *A, *B, *B2, *R; float* C; const int *list, *cnt; long bstride; int lda, ldb, ldc, M, N, K, lstride, ashift; };
template <bool DUAL>
__global__ void __launch_bounds__(256) k_sgemm(SgP p) {
    __shared__ float As[16][68]; __shared__ float Bs[16][64]; __shared__ float Bs2[DUAL ? 16 : 1][64];
    const int tid = threadIdx.x, tx = tid & 15, ty = tid >> 4, e = blockIdx.z;
    int M = p.M; const int* lst = nullptr;
    if (p.list) { M = p.cnt[e]; lst = p.list + (size_t)e * p.lstride; }
    const int m0 = blockIdx.y * 64, n0 = blockIdx.x * 64;
    if (m0 >= M) return;
    const float* B = p.B + (size_t)e * p.bstride; const float* B2 = DUAL ? p.B2 + (size_t)e * p.bstride : nullptr;
    const int ar = tid >> 2, ac = (tid & 3) * 4; int arow = m0 + ar; bool aval = arow < M; long asrc = 0;
    if (aval) { if (lst) { const int a = lst[arow]; asrc = (long)(a >> p.ashift); } else asrc = arow; }
    const float* Ap = p.A + (size_t)asrc * p.lda + ac;
    const int br = tid >> 4, bc = (tid & 15) * 4;
    float acc[4][4], acc2[4][4];
#pragma unroll
    for (int i = 0; i < 4; ++i)
#pragma unroll
        for (int j = 0; j < 4; ++j) { acc[i][j] = 0.f; acc2[i][j] = 0.f; }
    for (int k0 = 0; k0 < p.K; k0 += 16) {
        float4 av = aval ? *(const float4*)(Ap + k0) : make_float4(0.f, 0.f, 0.f, 0.f);
        float4 bv = *(const float4*)(B + (size_t)(k0 + br) * p.ldb + n0 + bc);
        float4 bv2 = make_float4(0.f, 0.f, 0.f, 0.f); if (DUAL) bv2 = *(const float4*)(B2 + (size_t)(k0 + br) * p.ldb + n0 + bc);
        __syncthreads();
        As[ac + 0][ar] = av.x; As[ac + 1][ar] = av.y; As[ac + 2][ar] = av.z; As[ac + 3][ar] = av.w;
        *(float4*)&Bs[br][bc] = bv; if (DUAL) *(float4*)&Bs2[br][bc] = bv2;
        __syncthreads();
#pragma unroll
        for (int k = 0; k < 16; ++k) {
            float a[4], b[4], b2[4];
#pragma unroll
            for (int i = 0; i < 4; ++i) a[i] = As[k][ty * 4 + i];
#pragma unroll
            for (int j = 0; j < 4; ++j) { b[j] = Bs[k][tx * 4 + j]; b2[j] = DUAL ? Bs2[k][tx * 4 + j] : 0.f; }
#pragma unroll
            for (int i = 0; i < 4; ++i)
#pragma unroll
                for (int j = 0; j < 4; ++j) { acc[i][j] += a[i] * b[j]; if (DUAL) acc2[i][j] += a[i] * b2[j]; }
        }
    }
#pragma unroll
    for (int i = 0; i < 4; ++i) {
        const int r = m0 + ty * 4 + i; if (r >= M) continue;
        const long crow = lst ? (long)lst[r] : (long)r;
        float* cp = p.C + (size_t)crow * p.ldc + n0 + tx * 4;
        float o[4];
#pragma unroll
        for (int j = 0; j < 4; ++j) { float v = acc[i][j]; if (DUAL) { const float g = v; v = g / (1.0f + __expf(-g)) * acc2[i][j]; } if (p.R) v += p.R[(size_t)crow * p.ldc + n0 + tx * 4 + j]; o[j] = v; }
        *(float4*)cp = make_float4(o[0], o[1], o[2], o[3]);
    }
}
__global__ void __launch_bounds__(256) k_attn(const float* proj, float* out, int out_pitch) {
    const int t = blockIdx.x * 256 + threadIdx.x, h = blockIdx.y, b = blockIdx.z;
    const float* base = proj + (size_t)b * NS * NIN;
    float q[64], acc[64];
    const float* qp = base + (size_t)t * NIN + h * 64;
#pragma unroll
    for (int d = 0; d < 64; d += 4) { const float4 v = *(const float4*)(qp + d); q[d] = v.x * 0.125f; q[d + 1] = v.y * 0.125f; q[d + 2] = v.z * 0.125f; q[d + 3] = v.w * 0.125f; }
#pragma unroll
    for (int d = 0; d < 64; ++d) acc[d] = 0.f;
    float carry = 1.0f;
    for (int s = t - 1; s >= 0; --s) {
        const float* kp = base + (size_t)s * NIN + 512 + h * 64; const float* vp = kp + 512;
        float z = 0.f;
#pragma unroll
        for (int d = 0; d < 64; d += 4) { const float4 kv = *(const float4*)(kp + d); z += q[d] * kv.x + q[d + 1] * kv.y + q[d + 2] * kv.z + q[d + 3] * kv.w; }
        const float ez = __expf(fminf(z, 80.f)); const float nb = 1.0f / (1.0f + ez); const float beta = ez * nb;
        const float w = beta * carry; carry *= nb;
#pragma unroll
        for (int d = 0; d < 64; d += 4) { const float4 vv = *(const float4*)(vp + d); acc[d] += w * vv.x; acc[d + 1] += w * vv.y; acc[d + 2] += w * vv.z; acc[d + 3] += w * vv.w; }
    }
    float* op = out + ((size_t)b * NS + t) * out_pitch + h * 64;
#pragma unroll
    for (int d = 0; d < 64; d += 4) *(float4*)(op + d) = make_float4(acc[d], acc[d + 1], acc[d + 2], acc[d + 3]);
}
__global__ void k_conv(const float* proj, const float* cw, const float* cb, float* xc) {
    const size_t i = (size_t)blockIdx.x * 256 + threadIdx.x; const int c = (int)(i & 511); const int m = (int)(i >> 9); const int t = m & (NS - 1);
    float s = cb[c];
#pragma unroll
    for (int j = 0; j < 4; ++j) { const int tt = t - 3 + j; if (tt >= 0) s += cw[j * 512 + c] * proj[(size_t)(m - 3 + j) * NIN + 1536 + c]; }
    xc[i] = s;
}
__global__ void k_gate(const float* xc, const float* wr, const float* br, const float* wi, const float* bi, const float* lam, float* aa, float* uu) {
    const size_t i = (size_t)blockIdx.x * 256 + threadIdx.x; const int c = (int)(i & 511); const size_t m = i >> 9; const int n = c >> 6, d = c & 63;
    const float* xr = xc + m * 512 + n * 64; float sr = br[c], si = bi[c];
    for (int k = 0; k < 64; ++k) { const float x = xr[k]; sr += x * wr[(n * 64 + k) * 64 + d]; si += x * wi[(n * 64 + k) * 64 + d]; }
    const float r = 1.0f / (1.0f + __expf(-sr)), ig = 1.0f / (1.0f + __expf(-si));
    const float l = lam[c]; const float lsg = fminf(l, 0.f) - log1pf(__expf(-fabsf(l)));
    const float la = 8.0f * r * lsg; const float a = __expf(la); const float mult = sqrtf(-expm1f(2.0f * la));
    aa[i] = a; uu[i] = mult * (ig * xc[i]);
}
__global__ void k_scan(const float* aa, const float* uu, const float* proj, float* out, int out_pitch) {
    const int i = blockIdx.x * 64 + threadIdx.x; const int c = i & 511, b = i >> 9; float h = 0.f;
#pragma unroll 8
    for (int t = 0; t < NS; ++t) { const size_t m = (size_t)b * NS + t; h = aa[m * 512 + c] * h + uu[m * 512 + c];
        const float g = proj[m * NIN + 2048 + c]; const float ge = 0.5f * g * (1.0f + tanhf(0.7978845608028654f * (g + 0.044715f * g * g * g)));
        out[m * out_pitch + 512 + c] = h * ge; }
}
__global__ void k_route(const float* h, const float* g2, const float* wg, const float* bg, const float* wf, const float* bf, float* u2, int* eid, float* ew, int* cnt, int* list) {
    const int gw = (blockIdx.x * blockDim.x + threadIdx.x) >> 6, lane = threadIdx.x & 63, nw = (gridDim.x * blockDim.x) >> 6;
    for (int m = gw; m < NM; m += nw) {
        const float* p = h + (size_t)m * ND; float v[16]; float s = 0.f;
#pragma unroll
        for (int j = 0; j < 16; ++j) { v[j] = p[lane + 64 * j]; s += v[j] * v[j]; }
        s = wsum(s); const float ri = 1.0f / sqrtf(s * (1.0f / ND) + NEPS);
#pragma unroll
        for (int j = 0; j < 16; ++j) { v[j] = v[j] * ri * g2[lane + 64 * j]; u2[(size_t)m * ND + lane + 64 * j] = v[j]; }
        float gl[4];
#pragma unroll
        for (int q = 0; q < 4; ++q) { float a = 0.f;
#pragma unroll
            for (int j = 0; j < 16; ++j) a += v[j] * wg[(lane + 64 * j) * 4 + q];
            gl[q] = wsum(a) + bg[q]; }
        int gi = 0; float gm = gl[0];
#pragma unroll
        for (int q = 1; q < 4; ++q) if (gl[q] > gm) { gm = gl[q]; gi = q; }
        float gs = 0.f;
#pragma unroll
        for (int q = 0; q < 4; ++q) gs += __expf(gl[q] - gm);
        const float gp = 1.0f / gs;
        float fl[8];
#pragma unroll
        for (int q = 0; q < 8; ++q) { float a = 0.f;
#pragma unroll
            for (int j = 0; j < 16; ++j) a += v[j] * wf[(lane + 64 * j) * 32 + gi * 8 + q];
            fl[q] = wsum(a) + bf[gi * 8 + q]; }
        int i0 = 0; float m0 = fl[0];
#pragma unroll
        for (int q = 1; q < 8; ++q) if (fl[q] > m0) { m0 = fl[q]; i0 = q; }
        int i1 = -1; float m1 = -3.0e38f;
#pragma unroll
        for (int q = 0; q < 8; ++q) if (q != i0 && fl[q] > m1) { m1 = fl[q]; i1 = q; }
        const float e1 = __expf(m1 - m0); const float p0 = 1.0f / (1.0f + e1), p1 = e1 * p0;
        if (lane == 0) {
            const int e0 = gi * 8 + i0, e1i = gi * 8 + i1;
            eid[m * 2] = e0; eid[m * 2 + 1] = e1i; ew[m * 2] = gp * p0; ew[m * 2 + 1] = gp * p1;
            int pos = atomicAdd(&cnt[e0], 1); list[(size_t)e0 * NM + pos] = m * 2;
            pos = atomicAdd(&cnt[e1i], 1); list[(size_t)e1i * NM + pos] = m * 2 + 1;
        }
    }
}
__global__ void k_final(const float* h, const float* y, const float* ew, const float* g, float* out) {
    const int gw = (blockIdx.x * blockDim.x + threadIdx.x) >> 6, lane = threadIdx.x & 63, nw = (gridDim.x * blockDim.x) >> 6;
    for (int m = gw; m < NM; m += nw) {
        const float w0 = ew[m * 2], w1 = ew[m * 2 + 1]; float v[16]; float s = 0.f;
#pragma unroll
        for (int j = 0; j < 16; ++j) { const int c = lane + 64 * j; v[j] = h[(size_t)m * ND + c] + w0 * y[(size_t)(2 * m) * ND + c] + w1 * y[(size_t)(2 * m + 1) * ND + c]; s += v[j] * v[j]; }
        s = wsum(s); const float ri = 1.0f / sqrtf(s * (1.0f / ND) + NEPS);
#pragma unroll
        for (int j = 0; j < 16; ++j) { const int c = lane + 64 * j; out[(size_t)m * ND + c] = v[j] * ri * g[c]; }
    }
}
}
extern "C" void kernel_launch(void* const* d_in, const int* in_sizes, int n_in, void* d_out, int out_size, void* d_ws, size_t ws_size, hipStream_t stream) {
    using namespace nv;
    const size_t MiB = 1u << 20;
    if (n_in != 22 || out_size != NM * ND || ws_size < 260 * MiB) { fprintf(stderr, "kernel_launch: unexpected shapes (n_in %d out %d ws %zu)\n", n_in, out_size, ws_size); return; }
    const float* x = (const float*)d_in[0]; const float* g1 = (const float*)d_in[1]; const float* w_in = (const float*)d_in[2];
    const float* conv_w = (const float*)d_in[3]; const float* conv_b = (const float*)d_in[4]; const float* w_r = (const float*)d_in[5]; const float* b_r = (const float*)d_in[6];
    const float* w_i = (const float*)d_in[7]; const float* b_i = (const float*)d_in[8]; const float* lam = (const float*)d_in[9];
    const float* sbg = (const float*)d_in[10]; const float* lrg = (const float*)d_in[11]; const float* w_out = (const float*)d_in[12]; const float* g2 = (const float*)d_in[13];
    const float* w_grp = (const float*)d_in[14]; const float* b_grp = (const float*)d_in[15]; const float* w_fine = (const float*)d_in[16]; const float* b_fine = (const float*)d_in[17];
    const float* w_eg = (const float*)d_in[18]; const float* w_eu = (const float*)d_in[19]; const float* w_ed = (const float*)d_in[20]; const float* gf = (const float*)d_in[21];
    char* ws = (char*)d_ws; float* out = (float*)d_out;
    float* RA = (float*)(ws);
    float* PROJ = (float*)(ws + 64 * MiB);
    float* XC = (float*)(ws + 224 * MiB);
    float* AA = out; float* UU = out + (size_t)NM * 512;
    float* ACT = (float*)(ws + 64 * MiB); float* Y = (float*)(ws + 128 * MiB);
    int* cnt = (int*)(ws + 256 * MiB); int* eid = (int*)(ws + 256 * MiB + 4096); float* ew = (float*)(ws + 256 * MiB + 4096 + NM * 8); int* list = (int*)(ws + 257 * MiB);
    (void)hipMemsetAsync(cnt, 0, 4096, stream);
    k_rms<16><<<2048, 256, 0, stream>>>(x, ND, g1, RA, ND, NM);
    { SgP p{}; p.A = RA; p.lda = ND; p.B = w_in; p.ldb = NIN; p.C = PROJ; p.ldc = NIN; p.M = NM; p.N = NIN; p.K = ND;
      k_sgemm<false><<<dim3(NIN / 64, NM / 64, 1), 256, 0, stream>>>(p); }
    k_attn<<<dim3(NS / 256, 8, NB), 256, 0, stream>>>(PROJ, RA, ND);
    k_conv<<<NM * 512 / 256, 256, 0, stream>>>(PROJ, conv_w, conv_b, XC);
    k_gate<<<NM * 512 / 256, 256, 0, stream>>>(XC, w_r, b_r, w_i, b_i, lam, AA, UU);
    k_scan<<<16, 64, 0, stream>>>(AA, UU, PROJ, RA, ND);
    k_rms<8><<<2048, 256, 0, stream>>>(RA, ND, sbg, RA, ND, NM);
    k_rms<8><<<2048, 256, 0, stream>>>(RA + 512, ND, lrg, RA + 512, ND, NM);
    { SgP p{}; p.A = RA; p.lda = ND; p.B = w_out; p.ldb = ND; p.C = out; p.ldc = ND; p.R = x; p.M = NM; p.N = ND; p.K = ND;
      k_sgemm<false><<<dim3(ND / 64, NM / 64, 1), 256, 0, stream>>>(p); }
    k_route<<<2048, 256, 0, stream>>>(out, g2, w_grp, b_grp, w_fine, b_fine, RA, eid, ew, cnt, list);
    { SgP p{}; p.A = RA; p.lda = ND; p.B = w_eg; p.B2 = w_eu; p.ldb = NDE; p.C = ACT; p.ldc = NDE; p.M = NM; p.N = NDE; p.K = ND;
      p.list = list; p.cnt = cnt; p.lstride = NM; p.bstride = (long)ND * NDE; p.ashift = 1;
      k_sgemm<true><<<dim3(NDE / 64, NM / 64, NE), 256, 0, stream>>>(p); }
    { SgP p{}; p.A = ACT; p.lda = NDE; p.B = w_ed; p.ldb = ND; p.C = Y; p.ldc = ND; p.M = NM; p.N = ND; p.K = NDE;
      p.list = list; p.cnt = cnt; p.lstride = NM; p.bstride = (long)NDE * ND; p.ashift = 0;
      k_sgemm<false><<<dim3(ND / 64, NM / 64, NE), 256, 0, stream>>>(p); }
    k_final<<<2048, 256, 0, stream>>>(out, Y, ew, gf, out);
}
```

```cpp
#define HYB 4
#define SPLIT_LAUNCH 0
#include <hip/hip_runtime.h>
#include <cstdio>
#include <cstdint>
namespace pg8 {
#define PG8_LAS __attribute__((address_space(3)))
typedef unsigned short bf16_t;
typedef short bf16x8 __attribute__((ext_vector_type(8)));
typedef float f32x4 __attribute__((ext_vector_type(4)));
typedef unsigned u32x4 __attribute__((ext_vector_type(4)));
constexpr int BM = 256, BK = 64, HALF = 128, HTB = HALF * BK * 2  , STAGE_BYTES = 8 * HTB, NXCD = 8, WGM = 8;

__host__ __device__ __forceinline__ int lds_byte(int r, int c) { const int st = (r >> 4) * 2 + (c >> 5), rr = r & 15, cc = c & 31, ob = rr * 64 + cc * 2; return st * 1024 + (ob ^ (((ob >> 9) & 1) << 5)); }
__host__ __device__ __forceinline__ void stage_rc(int b, int& R, int& C) { const int st = b / 1024, sb = b % 1024, swz = sb ^ (((sb >> 9) & 1) << 5); R = (st >> 1) * 16 + swz / 64; C = (st & 1) * 32 + (swz % 64) / 2; }
__host__ __device__ __forceinline__ int perm32(int rho) { const int n = rho >> 4, i = rho & 15; return 8 * (i >> 2) + 4 * n + (i & 3); }

struct Unit { int pm, pn; };
struct Gemm { const bf16_t* A; const bf16_t* Bt; int M, N, K; };

struct StaticOrder {
    int nM, nN, nwg, G, c;
    __host__ __device__ void init(int M, int N, int G_, int c_) { nM = M / BM; nN = N / BM; nwg = nM * nN; G = G_; c = c_; }
    __host__ __device__ bool next(int i, Unit& u) const {
        const long L = (long)i * G + c; if (L >= nwg) return false;
        int wgid = (int)L; { const int q = nwg / NXCD, r = nwg % NXCD, xcd = wgid % NXCD, off = wgid / NXCD; wgid = (xcd < r ? xcd * (q + 1) : r * (q + 1) + (xcd - r) * q) + off; }
        const int nig = WGM * nN, gid = wgid / nig, fm = gid * WGM, gsz = (nM - fm) < WGM ? (nM - fm) : WGM;
        u.pm = fm + ((wgid % nig) % gsz); u.pn = (wgid % nig) / gsz; return true;
    }
    __device__ __forceinline__ void a_ready(const Unit&) const {}
    __device__ __forceinline__ void done(const Unit&) const {}
};

__device__ __forceinline__ unsigned cvt_pk_bf16(float lo, float hi) { unsigned r; asm volatile("v_cvt_pk_bf16_f32 %0, %1, %2" : "=v"(r) : "v"(lo), "v"(hi)); return r; }
typedef float f32x2 __attribute__((ext_vector_type(2)));
__device__ __forceinline__ f32x2 gelu_pk(f32x2 v) {
    const f32x2 av = __builtin_elementwise_abs(v), d = av * 0.2316418882f + 1.0f;
    f32x2 t; t.x = __builtin_amdgcn_rcpf(d.x); t.y = __builtin_amdgcn_rcpf(d.y);
    f32x2 q = t * 0.5307027145f + (-0.7265760135f); q = q * t + 0.7107068705f; q = q * t + (-0.142248368f); q = q * t + 0.127414796f; q = q * t;
    const f32x2 s = (v * v) * (-0.72134752044f);
    f32x2 e; e.x = __builtin_amdgcn_exp2f(s.x); e.y = __builtin_amdgcn_exp2f(s.y);
    const f32x2 m = v * (q * e), r = v - m;
    f32x2 o; o.x = v.x < 0.f ? m.x : r.x; o.y = v.y < 0.f ? m.y : r.y; return o;
}

template <int ACT  > struct EpiBf16 {
    static constexpr bool PERM = true, AFTER_DRAIN = false; static_assert(ACT == 0 || ACT == 1, "EpiBf16: ACT is 0 (none) or 1 (gelu_pk)");
    bf16_t* O; int ldc; const float* bias; int split_cols; size_t split_stride; float scale0;
    __device__ __forceinline__ void operator()(const f32x4 (&acc)[2][2][4][2], const Unit& u, int wr, int wc, int fr, int fq) const {
        const int row0 = u.pm * BM + wr * 64 + fr; int colt = u.pn * BM; bf16_t* base = O;
        float sc = 1.f; if (split_cols) { const int t = colt / split_cols; base += (size_t)t * split_stride; colt -= t * split_cols; if (t == 0) sc = scale0; }
        const int col0 = colt + wc * 32 + 8 * fq, bcol0 = u.pn * BM + wc * 32 + 8 * fq;
        f32x4 bv[2][2];
#pragma unroll
        for (int bj = 0; bj < 2; ++bj)
#pragma unroll
            for (int n = 0; n < 2; ++n) bv[bj][n] = bias ? *(const f32x4*)(bias + bcol0 + bj * HALF + 4 * n) : (f32x4){0.f, 0.f, 0.f, 0.f};
#pragma unroll
        for (int ai = 0; ai < 2; ++ai)
#pragma unroll
            for (int m = 0; m < 4; ++m) { bf16_t* rowp = base + (size_t)(row0 + ai * HALF + m * 16) * ldc + col0;
#pragma unroll
                for (int bj = 0; bj < 2; ++bj) { f32x4 v0 = acc[ai][bj][m][0] + bv[bj][0], v1 = acc[ai][bj][m][1] + bv[bj][1];
                    if (ACT == 1) { f32x2 a = gelu_pk((f32x2){v0[0], v0[1]}), b = gelu_pk((f32x2){v0[2], v0[3]}), c = gelu_pk((f32x2){v1[0], v1[1]}), d = gelu_pk((f32x2){v1[2], v1[3]});
                        v0 = (f32x4){a.x, a.y, b.x, b.y}; v1 = (f32x4){c.x, c.y, d.x, d.y}; }
                    v0 = v0 * sc; v1 = v1 * sc; u32x4 w; w.x = cvt_pk_bf16(v0[0], v0[1]); w.y = cvt_pk_bf16(v0[2], v0[3]); w.z = cvt_pk_bf16(v1[0], v1[1]); w.w = cvt_pk_bf16(v1[2], v1[3]);
                    *(u32x4*)(rowp + bj * HALF) = w; } }
    }
};

struct EpiResF32 {
    static constexpr bool PERM = false, AFTER_DRAIN = false;
    const float* X; float* O; int ldc;
    __device__ __forceinline__ void operator()(const f32x4 (&acc)[2][2][4][2], const Unit& u, int wr, int wc, int fr, int fq) const {
        const int row0 = u.pm * BM + wr * 64 + fr, col0 = u.pn * BM + wc * 32 + 4 * fq;
#pragma unroll
        for (int ai = 0; ai < 2; ++ai)
#pragma unroll
            for (int m = 0; m < 4; ++m) { const size_t off = (size_t)(row0 + ai * HALF + m * 16) * ldc + col0;
#pragma unroll
                for (int bj = 0; bj < 2; ++bj)
#pragma unroll
                    for (int n = 0; n < 2; ++n) { const f32x4 xv = *(const f32x4*)(X + off + bj * HALF + n * 16); *(f32x4*)(O + off + bj * HALF + n * 16) = acc[ai][bj][m][n] + xv; } }
    }
};
struct EpiGateUp {
    static constexpr bool PERM = true, AFTER_DRAIN = false;
    bf16_t* O;
    __device__ __forceinline__ void operator()(const f32x4 (&acc)[2][2][4][2], const Unit& u, int wr, int wc, int fr, int fq) const {
        const int row0 = u.pm * BM + wr * 64 + fr, col0 = (u.pn & 3) * HALF + wc * 32 + 8 * fq;
#pragma unroll
        for (int ai = 0; ai < 2; ++ai)
#pragma unroll
            for (int m = 0; m < 4; ++m) { bf16_t* rowp = O + (size_t)(row0 + ai * HALF + m * 16) * 512 + col0;
                float v[8];
#pragma unroll
                for (int n = 0; n < 2; ++n)
#pragma unroll
                    for (int i = 0; i < 4; ++i) { const float g = acc[ai][0][m][n][i], up = acc[ai][1][m][n][i];
                        const float e = __builtin_amdgcn_exp2f(-1.4426950408889634f * g); v[n * 4 + i] = g * __builtin_amdgcn_rcpf(1.0f + e) * up; }
                u32x4 w; w.x = cvt_pk_bf16(v[0], v[1]); w.y = cvt_pk_bf16(v[2], v[3]); w.z = cvt_pk_bf16(v[4], v[5]); w.w = cvt_pk_bf16(v[6], v[7]);
                *(u32x4*)rowp = w; }
    }
};
struct MoeOrder {
    const PG8_LAS int* tile_e; int nunit, G, c;
    __device__ __forceinline__ bool next(int i, Unit& u) const {
        const long L = (long)i * G + c; if (L >= nunit) return false;
        const int pm = (int)(L >> 2); const int e = tile_e[pm]; u.pm = pm; u.pn = e * 4 + (int)(L & 3); return true;
    }
    __device__ __forceinline__ void a_ready(const Unit&) const {}
    __device__ __forceinline__ void done(const Unit&) const {}
};
template <class Epi, class Sched, bool ALIGN_EPI = false, bool SP2 = false>
__device__ __forceinline__ void gemm_phase(PG8_LAS unsigned char* lds, const Gemm g, const Sched& S, const Epi& E) {
    const int tid = threadIdx.x, wid = __builtin_amdgcn_readfirstlane(tid >> 6), lane = tid & 63, wr = wid >> 2, wc = wid & 3, fr = lane & 15, fq = lane >> 4;
    const int K = g.K, nt = K / BK;
    unsigned voffA[2], voffB[2];
#pragma unroll
    for (int i = 0; i < 2; ++i) { int R, C; stage_rc(tid * 16 + i * 8192, R, C); const int Rb = Epi::PERM ? ((R & ~31) + perm32(R & 31)) : R;
        voffA[i] = (unsigned)(R * K + C) * 2u; voffB[i] = (unsigned)(Rb * K + C) * 2u; }
    const size_t kstep = (size_t)(BK * 2);
    const size_t hstep = (size_t)HALF * K * 2;
    const size_t tstep = 2 * hstep;
    const unsigned ldsw = (unsigned)wid * 1024u;
    const int aoff = lds_byte(wr * 64 + fr, fq * 8), boff = lds_byte(wc * 32 + fr, fq * 8);
#define PG8_SA(b, h) (((b) * 2 + (h)) * HTB)
#define PG8_SB(b, h) ((4 + (b) * 2 + (h)) * HTB)
#define PG8_STAGE(bufoff, gbase, voff) do { _Pragma("unroll") for (int _i = 0; _i < 2; ++_i) \
        __builtin_amdgcn_global_load_lds((const unsigned*)((const char*)(gbase) + (voff)[_i]), (PG8_LAS unsigned*)(lds + (bufoff) + ldsw + _i * 8192), 16, 0, 0); } while (0)
#define PG8_LDA(dst, b, h) do { _Pragma("unroll") for (int m = 0; m < 4; ++m) _Pragma("unroll") for (int k = 0; k < 2; ++k) dst[m][k] = *(const PG8_LAS bf16x8*)(lds + PG8_SA(b, h) + aoff + m * 2048 + k * 1024); } while (0)
#define PG8_LDB(dst, b, h) do { _Pragma("unroll") for (int n = 0; n < 2; ++n) _Pragma("unroll") for (int k = 0; k < 2; ++k) dst[n][k] = *(const PG8_LAS bf16x8*)(lds + PG8_SB(b, h) + boff + n * 2048 + k * 1024); } while (0)
#define PG8_MMA(ai, bj, At, Bt) do { __builtin_amdgcn_s_setprio(1); _Pragma("unroll") for (int m = 0; m < 4; ++m) _Pragma("unroll") for (int n = 0; n < 2; ++n) _Pragma("unroll") for (int k = 0; k < 2; ++k) \
        acc[ai][bj][m][n] = __builtin_amdgcn_mfma_f32_16x16x32_bf16(Bt[n][k], At[m][k], acc[ai][bj][m][n], 0, 0, 0); __builtin_amdgcn_s_setprio(0); } while (0)
#define PG8_WAIT_V(n) asm volatile("s_waitcnt vmcnt(" #n ")" ::: "memory")
#define PG8_WAIT_L(n) asm volatile("s_waitcnt lgkmcnt(" #n ")" ::: "memory")
#define PG8_BAR __builtin_amdgcn_s_barrier()
#define PG8_SCHED __builtin_amdgcn_sched_barrier(0)
    Unit cur, nxt; int ui = 0;
    if (!S.next(0, cur)) return;
    f32x4 acc[2][2][4][2];
#pragma unroll
    for (int a = 0; a < 2; ++a)
#pragma unroll
        for (int b = 0; b < 2; ++b)
#pragma unroll
            for (int m = 0; m < 4; ++m)
#pragma unroll
                for (int n = 0; n < 2; ++n) acc[a][b][m][n] = (f32x4){0.f, 0.f, 0.f, 0.f};
    bf16x8 At[4][2], B0[2][2], B1[2][2];
    const char* cA = (const char*)g.A + (size_t)cur.pm * tstep; const char* cB = (const char*)g.Bt + (size_t)cur.pn * tstep;
    S.a_ready(cur);
    if constexpr (SP2) {
        PG8_STAGE(PG8_SB(0, 0), cB, voffB); PG8_STAGE(PG8_SB(0, 1), cB + hstep, voffB); PG8_STAGE(PG8_SA(0, 0), cA, voffA); PG8_STAGE(PG8_SA(0, 1), cA + hstep, voffA);
        if (wr == 1) PG8_BAR;
        PG8_WAIT_V(2); PG8_BAR;
        PG8_STAGE(PG8_SB(1, 0), cB + kstep, voffB); PG8_STAGE(PG8_SA(1, 0), cA + kstep, voffA); PG8_STAGE(PG8_SB(1, 1), cB + hstep + kstep, voffB);
        PG8_WAIT_V(6); PG8_BAR;
    } else {
        PG8_STAGE(PG8_SB(0, 0), cB, voffB); PG8_STAGE(PG8_SA(0, 0), cA, voffA); PG8_STAGE(PG8_SB(0, 1), cB + hstep, voffB); PG8_STAGE(PG8_SA(0, 1), cA + hstep, voffA);
        if (wr == 1) PG8_BAR;
        PG8_WAIT_V(4); PG8_BAR;
        PG8_STAGE(PG8_SB(1, 0), cB + kstep, voffB); PG8_STAGE(PG8_SA(1, 0), cA + kstep, voffA); PG8_STAGE(PG8_SB(1, 1), cB + hstep + kstep, voffB);
        PG8_WAIT_V(6); PG8_BAR;
    }
    for (;;) {
        const bool has_next = S.next(ui + 1, nxt);
        const char* nA = has_next ? (const char*)g.A + (size_t)nxt.pm * tstep : cA; const char* nB = has_next ? (const char*)g.Bt + (size_t)nxt.pn * tstep : cB;
        for (int t = 0; t < nt; t += 2) {
            const bool last = (t == nt - 2);
            const char* a1 = cA + (size_t)(t + 1) * kstep;
            const char* a2 = last ? nA : cA + (size_t)(t + 2) * kstep; const char* b2 = last ? nB : cB + (size_t)(t + 2) * kstep;
            const char* a3 = a2 + kstep; const char* b3 = b2 + kstep;
            if (last && has_next) S.a_ready(nxt);
            if constexpr (SP2) {
            PG8_LDB(B0, 0, 0); PG8_LDB(B1, 0, 1); PG8_SCHED; PG8_LDA(At, 0, 0); PG8_STAGE(PG8_SA(1, 1), a1 + hstep, voffA);
            PG8_WAIT_V(8); PG8_WAIT_L(0); PG8_BAR; PG8_MMA(0, 0, At, B0); PG8_MMA(0, 1, At, B1); PG8_BAR; PG8_SCHED;
            PG8_LDA(At, 0, 1); PG8_STAGE(PG8_SB(0, 0), b2, voffB); PG8_STAGE(PG8_SB(0, 1), b2 + hstep, voffB); PG8_STAGE(PG8_SA(0, 0), a2, voffA);
            PG8_WAIT_V(8); PG8_WAIT_L(0); PG8_BAR; PG8_MMA(1, 0, At, B0); PG8_MMA(1, 1, At, B1); PG8_BAR; PG8_SCHED;
            PG8_LDB(B0, 1, 0); PG8_LDB(B1, 1, 1); PG8_SCHED; PG8_LDA(At, 1, 0); PG8_STAGE(PG8_SA(0, 1), a2 + hstep, voffA);
            PG8_WAIT_V(8); PG8_WAIT_L(0); PG8_BAR; PG8_MMA(0, 0, At, B0); PG8_MMA(0, 1, At, B1); PG8_BAR; PG8_SCHED;
            PG8_LDA(At, 1, 1); PG8_STAGE(PG8_SB(1, 0), b3, voffB); PG8_STAGE(PG8_SB(1, 1), b3 + hstep, voffB); PG8_STAGE(PG8_SA(1, 0), a3, voffA);
            PG8_WAIT_V(8); PG8_WAIT_L(0); PG8_BAR; PG8_MMA(1, 0, At, B0); PG8_MMA(1, 1, At, B1); PG8_BAR; PG8_SCHED;
            } else {
            PG8_LDB(B0, 0, 0); PG8_SCHED; PG8_LDA(At, 0, 0); PG8_STAGE(PG8_SA(1, 1), a1 + hstep, voffA);
            PG8_WAIT_L(8); PG8_BAR; PG8_WAIT_L(0); PG8_MMA(0, 0, At, B0); PG8_BAR; PG8_SCHED;
            PG8_LDB(B1, 0, 1); PG8_STAGE(PG8_SB(0, 0), b2, voffB);
            PG8_BAR; PG8_WAIT_L(0); PG8_MMA(0, 1, At, B1); PG8_BAR;
            PG8_LDA(At, 0, 1); PG8_STAGE(PG8_SA(0, 0), a2, voffA);
            PG8_BAR; PG8_WAIT_L(0); PG8_MMA(1, 0, At, B0); PG8_BAR; PG8_SCHED;
            PG8_STAGE(PG8_SB(0, 1), b2 + hstep, voffB);
            PG8_WAIT_V(6); PG8_BAR; PG8_MMA(1, 1, At, B1); PG8_BAR;
            PG8_LDB(B0, 1, 0); PG8_SCHED; PG8_LDA(At, 1, 0); PG8_STAGE(PG8_SA(0, 1), a2 + hstep, voffA);
            PG8_WAIT_L(8); PG8_BAR; PG8_WAIT_L(0); PG8_MMA(0, 0, At, B0); PG8_BAR; PG8_SCHED;
            PG8_LDB(B1, 1, 1); PG8_STAGE(PG8_SB(1, 0), b3, voffB);
            PG8_BAR; PG8_WAIT_L(0); PG8_MMA(0, 1, At, B1); PG8_BAR;
            PG8_LDA(At, 1, 1); PG8_STAGE(PG8_SA(1, 0), a3, voffA);
            PG8_BAR; PG8_WAIT_L(0); PG8_MMA(1, 0, At, B0); PG8_BAR; PG8_SCHED;
            PG8_STAGE(PG8_SB(1, 1), b3 + hstep, voffB);
            PG8_WAIT_V(6); PG8_BAR; PG8_MMA(1, 1, At, B1); PG8_BAR;
            }
        }
        if constexpr (ALIGN_EPI) { if (wr == 0) PG8_BAR; }
        if constexpr (!Epi::AFTER_DRAIN) { E(acc, cur, wr, wc, fr, fq); S.done(cur); }
        if (!has_next) break;
#pragma unroll
        for (int a = 0; a < 2; ++a)
#pragma unroll
            for (int b = 0; b < 2; ++b)
#pragma unroll
                for (int m = 0; m < 4; ++m)
#pragma unroll
                    for (int n = 0; n < 2; ++n) acc[a][b][m][n] = (f32x4){0.f, 0.f, 0.f, 0.f};
        cur = nxt; cA = nA; cB = nB; ++ui;
        if constexpr (ALIGN_EPI) { if (wr == 1) PG8_BAR; }
    }
    PG8_WAIT_V(0);
    if constexpr (!ALIGN_EPI) { if (wr == 0) PG8_BAR; }
    PG8_BAR;
    if constexpr (Epi::AFTER_DRAIN) { E.fused(acc, cur, wr, wc, fr, fq, lds, wid, lane); S.done(cur); }
#undef PG8_SA
#undef PG8_SB
#undef PG8_STAGE
#undef PG8_LDA
#undef PG8_LDB
#undef PG8_MMA
#undef PG8_WAIT_V
#undef PG8_WAIT_L
#undef PG8_BAR
#undef PG8_SCHED
}
}
#define GAS __attribute__((address_space(1)))
#define LAS __attribute__((address_space(3)))
typedef unsigned short bf16;
typedef unsigned v4u __attribute__((ext_vector_type(4)));
typedef float f32x4 __attribute__((ext_vector_type(4)));
typedef short bf16x8 __attribute__((ext_vector_type(8)));
typedef GAS unsigned gu32;
typedef GAS unsigned long long gu64;
#define RLX_AGENT __ATOMIC_RELAXED, __HIP_MEMORY_SCOPE_AGENT
#define LDS_WAIT() asm volatile("s_waitcnt lgkmcnt(0)" ::: "memory")
#define VM_WAIT() asm volatile("s_waitcnt vmcnt(0)" ::: "memory")
__device__ __forceinline__ unsigned long long rt() { return __builtin_amdgcn_s_memrealtime(); }
__device__ __forceinline__ unsigned f2bf(float f) { unsigned u = __builtin_bit_cast(unsigned, f); return (u + 0x7fffu + ((u >> 16) & 1u)) >> 16; }
__device__ __forceinline__ unsigned pk2(float lo, float hi) { return f2bf(lo) | (f2bf(hi) << 16); }

#define XB_TMO      128
#define XB_XCNT(j)  (256  + 64 * (j))
#define XB_XSUB(j)  (1280 + 64 * (j))
#define XB_XGEN(j)  (2304 + 64 * (j))
#define XB_TOP      3328
#define XB_TOPGEN   3392
#define XCD_BAR_WORDS 3456
#define XB_SPIN_CAP (1u << 18)

__device__ __forceinline__ unsigned xb_ld(unsigned* p)              { return __hip_atomic_load(p, __ATOMIC_RELAXED, __HIP_MEMORY_SCOPE_AGENT); }
__device__ __forceinline__ unsigned xb_add(unsigned* p, unsigned v) { return __hip_atomic_fetch_add(p, v, __ATOMIC_RELAXED, __HIP_MEMORY_SCOPE_AGENT); }
__device__ __forceinline__ unsigned xb_xcc_id() { return (unsigned)__builtin_amdgcn_s_getreg((3 << 11) | 20) & 0xFu; }
#define XB_SPIN(cond, bar) do { unsigned _sp = 0; while (cond) { __builtin_amdgcn_s_sleep(1); \
    if ((++_sp & 255u) == 0u) { if (xb_ld(&(bar)[XB_TMO])) break; if (_sp > XB_SPIN_CAP) { atomicAdd(&(bar)[XB_TMO], 1u); break; } } } } while (0)

struct XcdBarrier {
    unsigned* bar; unsigned x;
    volatile LAS unsigned* st;
};

__device__ __forceinline__ XcdBarrier xcd_barrier_post(unsigned* bar, volatile LAS unsigned* st) {
    XcdBarrier b; b.bar = bar; b.x = xb_xcc_id(); b.st = st;
    if (threadIdx.x == 0) (void)xb_add(&bar[XB_XCNT(b.x)], 1u);
    return b;
}
__device__ __forceinline__ void xcd_barrier_complete(unsigned* bar, unsigned x, unsigned& nloc, unsigned& nx) {
    const unsigned G = gridDim.x * gridDim.y * gridDim.z;
    unsigned sum, cnt, mine, sp = 0u;
    for (;;) {
        sum = 0u; cnt = 0u; mine = 0u;
#pragma unroll
        for (unsigned j = 0; j < 16; ++j) { const unsigned c = xb_ld(&bar[XB_XCNT(j)]); sum += c; cnt += (c > 0u) ? 1u : 0u; mine = (j == x) ? c : mine; }
        if (sum == G) break;
        __builtin_amdgcn_s_sleep(1);
        if ((++sp & 255u) == 0u) { if (xb_ld(&bar[XB_TMO])) break; if (sp > XB_SPIN_CAP) { atomicAdd(&bar[XB_TMO], 1u); break; } }
    }
    nloc = mine > 0u ? mine : 1u; nx = cnt > 0u ? cnt : 1u;
}

__device__ __forceinline__ void xcd_barrier(const XcdBarrier& b) {
    asm volatile("s_waitcnt vmcnt(0)" ::: "memory");
    __syncthreads();
    if (threadIdx.x == 0) {
        unsigned* bar = b.bar;
        __builtin_amdgcn_s_waitcnt(0);
        unsigned nloc = b.st[0], nx = b.st[1];
        if (nloc == 0u) { xcd_barrier_complete(bar, b.x, nloc, nx); b.st[0] = nloc; b.st[1] = nx; }
        const unsigned old = xb_add(&bar[XB_XSUB(b.x)], 1u);
        const unsigned gen = old / nloc;
        if (old + 1u == (gen + 1u) * nloc) {
            __builtin_amdgcn_fence(__ATOMIC_RELEASE, "agent");
            asm volatile("s_waitcnt vmcnt(0)" ::: "memory");
            const unsigned og = xb_add(&bar[XB_TOP], 1u);
            const unsigned tg = og / nx;
            if (og + 1u == (tg + 1u) * nx) xb_add(&bar[XB_TOPGEN], 1u);
            else XB_SPIN(xb_ld(&bar[XB_TOPGEN]) == tg, bar);
            __builtin_amdgcn_fence(__ATOMIC_ACQUIRE, "agent");
            xb_add(&bar[XB_XGEN(b.x)], 1u);
            asm volatile("s_waitcnt vmcnt(0)" ::: "memory");
        } else {
            XB_SPIN(xb_ld(&bar[XB_XGEN(b.x)]) == gen, bar);
            __builtin_amdgcn_fence(__ATOMIC_ACQUIRE, "agent");
            asm volatile("s_waitcnt vmcnt(0)" ::: "memory");
        }
    }
    __syncthreads();
}

constexpr int NWAVES = 8;
constexpr int BATCH = 2, T = 8192, D = 1024, M = BATCH * T, NIN = 2560, HW = 512, NEXP = 32, DEXP = 512;
constexpr float EPS = 1e-6f, LOG2E = 1.4426950408889634f, C2 = 0.125f * LOG2E;
constexpr int XS_ROWS = 32768 + NEXP * 256;
constexpr int NCHUNK = T / 64;
constexpr size_t MiB = 1u << 20;
constexpr size_t WS_CTL = 0, CTL_ZERO_BYTES = 1 * MiB;
constexpr size_t WS_WIN = 1 * MiB, WS_WOUT = 6 * MiB, WS_WE1 = 8 * MiB, WS_WE2 = 72 * MiB, WS_SMALL = 104 * MiB;
constexpr size_t WS_XN = 108 * MiB;
constexpr size_t WS_PROJ = 140 * MiB;
constexpr size_t WS_R3 = 220 * MiB;
constexpr size_t WS_END = 260 * MiB;
constexpr size_t SM_WGT = 0, SM_WRH = 131072, SM_WRL = 229376, SM_SSQ = 327680, SM_AGGA = 851968, SM_AGGH = 1376256, SM_TOKE = 1900544, SM_TOKW = 2031616,
                 SM_TOKPOS = 2162688, SM_HIST = 2293760, SM_TILEE = 2326528;
constexpr int CW_TMO = 0, CW_CODE = 1, CW_BAR = 4096;
constexpr int RING_BYTES = 131072, LDSCTL_OFF = RING_BYTES, MISC_OFF = LDSCTL_OFF + 320, TAB_OFF = LDSCTL_OFF + 1024, LDS_BYTES = 147456;
constexpr int WAVE_LDS = 14336;

struct Frame {
    LAS unsigned char* lds; volatile LAS unsigned* MISC; gu32* ctl;
    int tid, lane, wave, vcu, G;
    float* out; unsigned char* ws;
};
__device__ __forceinline__ float wave_sum(float v) {
#pragma unroll
    for (int o = 1; o < 64; o <<= 1) v += __shfl_xor(v, o);
    return v;
}
__device__ __forceinline__ float bf2f(unsigned short v) { return __builtin_bit_cast(float, (unsigned)v << 16); }
typedef float f32x2_t __attribute__((ext_vector_type(2))); typedef __bf16 bf16x2_t __attribute__((ext_vector_type(2)));
__device__ __forceinline__ unsigned cvtpk(float lo, float hi) { f32x2_t v = {lo, hi}; bf16x2_t b = __builtin_convertvector(v, bf16x2_t); return __builtin_bit_cast(unsigned, b); }
typedef float f32x16 __attribute__((ext_vector_type(16)));
typedef short s16x4 __attribute__((ext_vector_type(4)));
__device__ __forceinline__ int crow(int r, int hi) { return (r & 3) + 8 * (r >> 2) + 4 * hi; }
#define CBAR() asm volatile("" ::: "memory")

__device__ __forceinline__ void tr_item(const float* W, int N, int k0, int n0, bf16* dst, int Kd, LAS float* scr, int lane) {
#pragma unroll 8
    for (int i = 0; i < 32; ++i) { const int kk = 2 * i + (lane >> 5); scr[kk * 33 + (lane & 31)] = W[(size_t)(k0 + kk) * N + n0 + (lane & 31)]; }
    LDS_WAIT(); CBAR();
    const int c = lane & 7;
#pragma unroll
    for (int j = 0; j < 4; ++j) { const int n = (lane >> 3) + 8 * j; const LAS float* s = scr + (8 * c) * 33 + n;
        v4u o; o.x = pk2(s[0 * 33], s[1 * 33]); o.y = pk2(s[2 * 33], s[3 * 33]); o.z = pk2(s[4 * 33], s[5 * 33]); o.w = pk2(s[6 * 33], s[7 * 33]);
        *(GAS v4u*)(dst + (size_t)n * Kd + k0 + 8 * c) = o; }
    LDS_WAIT(); CBAR();
}
__device__ __forceinline__ void rms_row_to_bf16(const float* xrow, const float* g, bf16* orow, int lane) {
    const GAS f32x4* xr = (const GAS f32x4*)xrow + lane; const GAS f32x4* gr = (const GAS f32x4*)g + lane;
    f32x4 v[4]; float s = 0.f;
#pragma unroll
    for (int j = 0; j < 4; ++j) { v[j] = xr[64 * j]; s += (v[j].x * v[j].x + v[j].y * v[j].y) + (v[j].z * v[j].z + v[j].w * v[j].w); }
    const float ri = 1.f / sqrtf(wave_sum(s) * (1.f / D) + EPS);
    GAS unsigned long long* o8 = (GAS unsigned long long*)orow + lane;
#pragma unroll
    for (int j = 0; j < 4; ++j) { const f32x4 gg = gr[64 * j];
        o8[64 * j] = (unsigned long long)pk2(v[j].x * ri * gg.x, v[j].y * ri * gg.y) | ((unsigned long long)pk2(v[j].z * ri * gg.z, v[j].w * ri * gg.w) << 32); }
}
__device__ __forceinline__ void p0_prologue(Frame& F, bool experts, const float* x, const float* g1, const float* w_in, const float* w_r, const float* w_i, const float* w_out,
        const float* g2, const float* w_grp, const float* w_fine, const float* w_eg, const float* w_eu, const float* w_ed) {
    LAS float* scr = (LAS float*)(F.lds + F.wave * 16384);
    const int gw = F.vcu * NWAVES + F.wave, NGW = F.G * NWAVES;
    unsigned char* ws = F.ws;
    bf16* WIN_T = (bf16*)(ws + WS_WIN); bf16* WOUT_T = (bf16*)(ws + WS_WOUT); bf16* WE1_T = (bf16*)(ws + WS_WE1); bf16* WE2_T = (bf16*)(ws + WS_WE2);
    constexpr int I_IN = 16 * 80, I_OUT = 16 * 32, I_GU = 16 * 16, I_DN = 8 * 32;
    const int NITEMS = I_IN + I_OUT + (experts ? NEXP * (2 * I_GU + I_DN) : 0);
    for (int it = gw; it < NITEMS; it += NGW) {
        int r = it;
        if (r < I_IN) { const int kb = r / 80, nb = r % 80; tr_item(w_in, NIN, 64 * kb, 32 * nb, WIN_T + (size_t)(32 * nb) * D, D, scr, F.lane); continue; } r -= I_IN;
        if (r < I_OUT) { const int kb = r / 32, nb = r % 32; tr_item(w_out, D, 64 * kb, 32 * nb, WOUT_T + (size_t)(32 * nb) * D, D, scr, F.lane); continue; } r -= I_OUT;
        if (r < NEXP * 2 * I_GU) { const int e = r / (2 * I_GU), rr = r % (2 * I_GU), mat = rr / I_GU, q = rr % I_GU, kb = q / 16, nb = q % 16, n0 = 32 * nb;
            const float* src = (mat ? w_eu : w_eg) + (size_t)e * D * DEXP; const int drow = 256 * (n0 >> 7) + (n0 & 127) + 128 * mat;
            tr_item(src, DEXP, 64 * kb, n0, WE1_T + ((size_t)e * 1024 + drow) * D, D, scr, F.lane); continue; } r -= NEXP * 2 * I_GU;
        { const int e = r / I_DN, q = r % I_DN, kb = q / 32, nb = q % 32;
            tr_item(w_ed + (size_t)e * DEXP * D, D, 64 * kb, 32 * nb, WE2_T + ((size_t)e * 1024 + 32 * nb) * DEXP, DEXP, scr, F.lane); }
    }
    bf16* XN = (bf16*)(ws + WS_XN);
    for (int m = gw; m < M; m += NGW) rms_row_to_bf16(x + (size_t)m * D, g1, XN + (size_t)m * D, F.lane);
    const int gt = gw * 64 + F.lane, NT = NGW * 64;
    bf16* WGT = (bf16*)(ws + WS_SMALL + SM_WGT);
    for (int i = gt; i < 2 * 8 * 64 * 64; i += NT) { const int gate = i >> 15, n = (i >> 12) & 7, d = (i >> 6) & 63, c = i & 63;
        WGT[i] = (bf16)f2bf((gate ? w_i : w_r)[(n * 64 + c) * 64 + d]); }
    bf16* WRH = (bf16*)(ws + WS_SMALL + SM_WRH); bf16* WRL = (bf16*)(ws + WS_SMALL + SM_WRL);
    for (int i = gt; i < 48 * 1024; i += NT) { const int rho = i >> 10, k = i & 1023; float w;
        if (rho < 16) w = w_grp[k * 4 + (rho & 3)];
        else { const int nt = rho >> 4, q = (rho >> 2) & 3, reg = rho & 3; w = w_fine[k * 32 + 8 * q + (nt == 2 ? 4 : 0) + reg]; }
        const float val = g2[k] * w; const unsigned h = f2bf(val); const float hf = __builtin_bit_cast(float, h << 16);
        WRH[i] = (bf16)h; WRL[i] = (bf16)f2bf(val - hf); }
}

__device__ __forceinline__ s16x4 vtr(const LAS char* p) { typedef short v4i16_t __attribute__((ext_vector_type(4)));
    return __builtin_bit_cast(s16x4, __builtin_amdgcn_ds_read_tr16_b64_v4i16((LAS v4i16_t*)p)); }
__device__ __forceinline__ void sb_item(const bf16* __restrict__ proj, bf16* out_sb, float* ssq, int b, int h, int qt, LAS char* wl, int lane) {
    const int r32 = lane & 31, hi = lane >> 5;
    const size_t rowbase = (size_t)b * T; const int t0 = qt * 32;
    const bf16* Qp = proj + (rowbase + t0 + r32) * NIN + h * 64 + hi * 8;
    bf16x8 qr[4];
#pragma unroll
    for (int d0 = 0; d0 < 4; ++d0) qr[d0] = *(const bf16x8*)(Qp + d0 * 16);
    const bf16* Kb = proj + rowbase * NIN + 512 + h * 64 + hi * 8;
    const bf16* Vb = proj + rowbase * NIN + 1024 + h * 64 + (lane & 3) * 8;
    f32x16 o0, o1;
#pragma unroll
    for (int r = 0; r < 16; ++r) { o0[r] = 0.f; o1[r] = 0.f; }
    float C = 1.0f;
    bf16x8 kc[4]; v4u vc[4];
#pragma unroll
    for (int d0 = 0; d0 < 4; ++d0) kc[d0] = *(const bf16x8*)(Kb + (size_t)(t0 + r32) * NIN + d0 * 16);
#pragma unroll
    for (int p = 0; p < 4; ++p) vc[p] = *(const v4u*)(Vb + (size_t)(t0 + (p & 1) * 16 + (lane >> 2)) * NIN + (p >> 1) * 32);
    const LAS char* vp0 = wl + ((lane >> 4) & 1) * 32 + (lane & 3) * 8 + (4 * hi + ((lane & 15) >> 2)) * 64;
    int buf = 0;
    for (int k0 = t0;; k0 -= 32) {
        const int kn0 = k0 >= 32 ? k0 - 32 : 0;
        bf16x8 kn[4]; v4u vn[4];
#pragma unroll
        for (int d0 = 0; d0 < 4; ++d0) kn[d0] = *(const bf16x8*)(Kb + (size_t)(kn0 + r32) * NIN + d0 * 16);
#pragma unroll
        for (int p = 0; p < 4; ++p) vn[p] = *(const v4u*)(Vb + (size_t)(kn0 + (p & 1) * 16 + (lane >> 2)) * NIN + (p >> 1) * 32);
        LAS char* vimg = wl + buf * 4096;
#pragma unroll
        for (int p = 0; p < 4; ++p) *(LAS v4u*)(vimg + p * 1024 + lane * 16) = vc[p];
        f32x16 p;
#pragma unroll
        for (int r = 0; r < 16; ++r) p[r] = 0.f;
#pragma unroll
        for (int d0 = 0; d0 < 4; ++d0) p = __builtin_amdgcn_mfma_f32_32x32x16_bf16(kc[d0], qr[d0], p, 0, 0, 0);
        float nb[16];
#pragma unroll
        for (int r = 0; r < 16; ++r) { const float e = __builtin_amdgcn_exp2f(p[r]); nb[r] = __builtin_amdgcn_rcpf(1.0f + e); }
        if (k0 == t0) {
#pragma unroll
            for (int r = 0; r < 16; ++r) if (crow(r, hi) >= r32) nb[r] = 1.0f;
        }
        float G[4], PG[4];
#pragma unroll
        for (int g = 0; g < 4; ++g) G[g] = (nb[4 * g] * nb[4 * g + 1]) * (nb[4 * g + 2] * nb[4 * g + 3]);
#pragma unroll
        for (int g = 0; g < 4; ++g) { const unsigned gu = __builtin_bit_cast(unsigned, G[g]); auto rr = __builtin_amdgcn_permlane32_swap(gu, gu, false, false);
            PG[g] = __builtin_bit_cast(float, hi ? rr[0] : rr[1]); }
        float Sg[4]; Sg[3] = C;
#pragma unroll
        for (int g = 3; g > 0; --g) Sg[g - 1] = Sg[g] * (G[g] * PG[g]);
        const float Cn = Sg[0] * (G[0] * PG[0]);
        float w[16];
#pragma unroll
        for (int g = 0; g < 4; ++g) { float E = hi ? Sg[g] : Sg[g] * PG[g];
#pragma unroll
            for (int m = 3; m >= 0; --m) { const float En = E * nb[4 * g + m]; w[4 * g + m] = E - En; E = En; } }
        C = Cn;
        v4u pw0, pw1;
        pw0.x = cvtpk(w[0], w[1]); pw0.y = cvtpk(w[2], w[3]); pw0.z = cvtpk(w[4], w[5]); pw0.w = cvtpk(w[6], w[7]);
        pw1.x = cvtpk(w[8], w[9]); pw1.y = cvtpk(w[10], w[11]); pw1.z = cvtpk(w[12], w[13]); pw1.w = cvtpk(w[14], w[15]);
        CBAR();
        const LAS char* vp = vp0 + buf * 4096;
        s16x4 vl[4], vh[4];
#pragma unroll
        for (int i = 0; i < 4; ++i) { vl[i] = vtr(vp + (i >> 1) * 2048 + (i & 1) * 1024); vh[i] = vtr(vp + (i >> 1) * 2048 + (i & 1) * 1024 + 512); }
#define VFR(i) (bf16x8){vl[i][0], vl[i][1], vl[i][2], vl[i][3], vh[i][0], vh[i][1], vh[i][2], vh[i][3]}
        o0 = __builtin_amdgcn_mfma_f32_32x32x16_bf16(__builtin_bit_cast(bf16x8, pw0), VFR(0), o0, 0, 0, 0);
        o0 = __builtin_amdgcn_mfma_f32_32x32x16_bf16(__builtin_bit_cast(bf16x8, pw1), VFR(1), o0, 0, 0, 0);
        o1 = __builtin_amdgcn_mfma_f32_32x32x16_bf16(__builtin_bit_cast(bf16x8, pw0), VFR(2), o1, 0, 0, 0);
        o1 = __builtin_amdgcn_mfma_f32_32x32x16_bf16(__builtin_bit_cast(bf16x8, pw1), VFR(3), o1, 0, 0, 0);
#undef VFR
        CBAR();
        if (k0 == 0) break;
        if (__all(C == 0.0f)) break;
#pragma unroll
        for (int d0 = 0; d0 < 4; ++d0) kc[d0] = kn[d0];
#pragma unroll
        for (int pp = 0; pp < 4; ++pp) vc[pp] = vn[pp];
        buf ^= 1;
    }
    LAS unsigned short* stg = (LAS unsigned short*)(wl + 8192);
#pragma unroll
    for (int r = 0; r < 16; ++r) { const int orow = crow(r, hi);
        stg[orow * 64 + r32] = (unsigned short)f2bf(o0[r]); stg[orow * 64 + 32 + r32] = (unsigned short)f2bf(o1[r]); }
    CBAR(); LDS_WAIT(); CBAR();
#pragma unroll
    for (int i = 0; i < 4; ++i) { const int row = i * 8 + (lane >> 3), ch = lane & 7;
        const v4u v = *(const LAS v4u*)(stg + row * 64 + ch * 8);
        *(GAS v4u*)(out_sb + (rowbase + t0 + row) * HW + h * 64 + ch * 8) = v;
        float s = 0.f;
#pragma unroll
        for (int j = 0; j < 4; ++j) { const float a = __builtin_bit_cast(float, v[j] << 16), c = __builtin_bit_cast(float, v[j] & 0xffff0000u); s += a * a + c * c; }
        s += __shfl_xor(s, 1); s += __shfl_xor(s, 2); s += __shfl_xor(s, 4);
        if (ch == 0) ssq[(rowbase + t0 + row) * 8 + h] = s; }
    CBAR(); LDS_WAIT(); CBAR();
}

__device__ __forceinline__ void lru_unit(const bf16* __restrict__ proj, const bf16* __restrict__ wgt, const float* conv_w, const float* conv_b, const float* b_r, const float* b_i,
                                         const float* lam, float* HLg, float* PCg, float* AGGA, float* AGGH, int b, int c, int n, LAS char* wl, int lane) {
    const int r32 = lane & 31, hi = lane >> 5;
    float Pa = 1.0f, Ha = 0.0f, Pb = 1.0f, Hb = 0.0f;
    LAS char* XT = wl; LAS char* GT = wl + 4608; LAS char* XCT = wl + 8704;
    for (int tile = 0; tile < 2; ++tile) {
        const int tt0 = c * 64 + tile * 32; const size_t m0 = (size_t)b * T + tt0;
#pragma unroll
        for (int q0 = 0; q0 < 320; q0 += 64) { const int q = q0 + lane; if (q < 280) { const int row = q >> 3, chunk = q & 7; v4u v = {0u, 0u, 0u, 0u};
                if (tt0 - 3 + row >= 0) v = *(const v4u*)(proj + (m0 + row - 3) * NIN + 1536 + n * 64 + chunk * 8);
                *(LAS v4u*)(XT + row * 128 + chunk * 16) = v; } }
#pragma unroll
        for (int q0 = 0; q0 < 256; q0 += 64) { const int q = q0 + lane; const int row = q >> 3, chunk = q & 7;
            *(LAS v4u*)(GT + row * 128 + chunk * 16) = *(const v4u*)(proj + (m0 + row) * NIN + 2048 + n * 64 + chunk * 8); }
        CBAR(); LDS_WAIT(); CBAR();
#pragma unroll 1
        for (int nh = 0; nh < 2; ++nh) { const int ch = n * 64 + nh * 32 + r32;
            const float c0 = conv_w[ch], c1 = conv_w[HW + ch], c2 = conv_w[2 * HW + ch], c3 = conv_w[3 * HW + ch], cb = conv_b[ch];
#pragma unroll
            for (int g = 0; g < 4; ++g) { const int tau0 = 8 * g + 4 * hi; float xs[7];
#pragma unroll
                for (int i = 0; i < 7; ++i) xs[i] = bf2f(*(const LAS unsigned short*)(XT + (tau0 + i) * 128 + (nh * 32 + r32) * 2));
#pragma unroll
                for (int m = 0; m < 4; ++m) { const float v = cb + ((c0 * xs[m] + c1 * xs[m + 1]) + (c2 * xs[m + 2] + c3 * xs[m + 3]));
                    *(LAS unsigned short*)(XCT + (tau0 + m) * 144 + (nh * 32 + r32) * 2) = (unsigned short)f2bf(v); } } }
        CBAR(); LDS_WAIT(); CBAR();
        bf16x8 xa[4];
#pragma unroll
        for (int ks = 0; ks < 4; ++ks) xa[ks] = *(const LAS bf16x8*)(XCT + r32 * 144 + ks * 32 + hi * 16);
#pragma unroll 1
        for (int nh = 0; nh < 2; ++nh) { const int ch = n * 64 + nh * 32 + r32;
            const float br = b_r[ch], bi = b_i[ch]; const float l = lam[ch];
            const float clam = 8.0f * LOG2E * (fminf(l, 0.f) - log1pf(__expf(-fabsf(l))));
            f32x16 ar, ai;
#pragma unroll
            for (int r = 0; r < 16; ++r) { ar[r] = 0.f; ai[r] = 0.f; }
            const bf16* wrp = wgt + ((size_t)(0 * 8 + n) * 64 + nh * 32 + r32) * 64 + hi * 8;
            const bf16* wip = wgt + ((size_t)(1 * 8 + n) * 64 + nh * 32 + r32) * 64 + hi * 8;
#pragma unroll
            for (int ks = 0; ks < 4; ++ks) { const bf16x8 wr8 = *(const bf16x8*)(wrp + ks * 16), wi8 = *(const bf16x8*)(wip + ks * 16);
                ar = __builtin_amdgcn_mfma_f32_32x32x16_bf16(xa[ks], wr8, ar, 0, 0, 0); ai = __builtin_amdgcn_mfma_f32_32x32x16_bf16(xa[ks], wi8, ai, 0, 0, 0); }
            float a[16], u[16];
#pragma unroll
            for (int r = 0; r < 16; ++r) {
                const float xc = bf2f(*(const LAS unsigned short*)(XCT + crow(r, hi) * 144 + (nh * 32 + r32) * 2));
                const float rg = __builtin_amdgcn_rcpf(1.0f + __builtin_amdgcn_exp2f(-LOG2E * (ar[r] + br)));
                const float ig = __builtin_amdgcn_rcpf(1.0f + __builtin_amdgcn_exp2f(-LOG2E * (ai[r] + bi)));
                const float av = __builtin_amdgcn_exp2f(rg * clam);
                a[r] = av; u[r] = __builtin_amdgcn_sqrtf(fmaxf(1.0f - av * av, 0.0f)) * (ig * xc); }
            float Ag[4], Bg[4], PAg[4], PBg[4];
#pragma unroll
            for (int g = 0; g < 4; ++g) { float A = a[4 * g], Bv = u[4 * g];
#pragma unroll
                for (int m = 1; m < 4; ++m) { A *= a[4 * g + m]; Bv = Bv * a[4 * g + m] + u[4 * g + m]; }
                Ag[g] = A; Bg[g] = Bv; }
#pragma unroll
            for (int g = 0; g < 4; ++g) { const unsigned ua = __builtin_bit_cast(unsigned, Ag[g]), ub = __builtin_bit_cast(unsigned, Bg[g]);
                auto ra = __builtin_amdgcn_permlane32_swap(ua, ua, false, false); auto rb = __builtin_amdgcn_permlane32_swap(ub, ub, false, false);
                PAg[g] = __builtin_bit_cast(float, hi ? ra[0] : ra[1]); PBg[g] = __builtin_bit_cast(float, hi ? rb[0] : rb[1]); }
            float P = nh ? Pb : Pa, H = nh ? Hb : Ha; float P0[4], H0[4];
#pragma unroll
            for (int g = 0; g < 4; ++g) {
                const float Alo = hi ? PAg[g] : Ag[g], Blo = hi ? PBg[g] : Bg[g], Ahi = hi ? Ag[g] : PAg[g], Bhi = hi ? Bg[g] : PBg[g];
                const float P1 = P * Alo, H1 = Alo * H + Blo;
                P0[g] = hi ? P1 : P; H0[g] = hi ? H1 : H;
                P = P1 * Ahi; H = Ahi * H1 + Bhi; }
            if (nh) { Pb = P; Hb = H; } else { Pa = P; Ha = H; }
            float* hl = HLg + n * 64 + nh * 32 + r32; float* pc = PCg + n * 64 + nh * 32 + r32;
#pragma unroll
            for (int g = 0; g < 4; ++g) { float Pv = P0[g], Hv = H0[g];
#pragma unroll
                for (int m = 0; m < 4; ++m) { const int r = 4 * g + m; Pv *= a[r]; Hv = a[r] * Hv + u[r];
                    const int tau = 8 * g + 4 * hi + m;
                    const float gv = bf2f(*(const LAS unsigned short*)(GT + tau * 128 + (nh * 32 + r32) * 2));
                    const float ge = gv * __builtin_amdgcn_rcpf(1.0f + __builtin_amdgcn_exp2f(-2.0f * LOG2E * 0.7978845608028654f * (gv + 0.044715f * gv * gv * gv)));
                    hl[(m0 + tau) * HW] = Hv * ge; pc[(m0 + tau) * HW] = Pv * ge; } }
        }
        CBAR(); LDS_WAIT(); CBAR();
    }
    if (hi == 0) { const size_t o = ((size_t)b * NCHUNK + c) * HW + n * 64 + r32; AGGA[o] = Pa; AGGH[o] = Ha; AGGA[o + 32] = Pb; AGGH[o + 32] = Hb; }
}
__device__ __forceinline__ void p2_mixer(Frame& F, const float* conv_w, const float* conv_b, const float* b_r, const float* b_i, const float* lam) {
    unsigned char* ws = F.ws;
    const bf16* PROJ = (const bf16*)(ws + WS_PROJ); const bf16* WGT = (const bf16*)(ws + WS_SMALL + SM_WGT);
    bf16* OUT_SB = (bf16*)(ws + WS_R3); float* SSQ = (float*)(ws + WS_SMALL + SM_SSQ);
    float* HLg = F.out; float* PCg = F.out + (size_t)M * HW;
    float* AGGA = (float*)(ws + WS_SMALL + SM_AGGA); float* AGGH = (float*)(ws + WS_SMALL + SM_AGGH);
    LAS char* wl = (LAS char*)(F.lds + F.wave * WAVE_LDS);
    const int gw = F.vcu * NWAVES + F.wave, NGW = F.G * NWAVES;
#ifndef NO_LRU
    for (int L = gw; L < BATCH * NCHUNK * 8; L += NGW) { const int n = L & 7, c = (L >> 3) & (NCHUNK - 1), b = L >> 10;
        lru_unit(PROJ, WGT, conv_w, conv_b, b_r, b_i, lam, HLg, PCg, AGGA, AGGH, b, c, n, wl, F.lane); }
#endif
#ifndef NO_SB
    for (int i = gw; i < BATCH * 8 * (T / 32); i += NGW) { const int qt = i & 255, bh = i >> 8;
        sb_item(PROJ, OUT_SB, SSQ, bh >> 3, bh & 7, qt, wl, F.lane); }
#endif
}

__device__ __forceinline__ void p3_mixnorm(Frame& F, const float* sbg, const float* lrg) {
    unsigned char* ws = F.ws;
    const bf16* OUT_SB = (const bf16*)(ws + WS_R3); const float* SSQ = (const float*)(ws + WS_SMALL + SM_SSQ);
    const float* HLg = F.out; const float* PCg = F.out + (size_t)M * HW;
    const float* AGGA = (const float*)(ws + WS_SMALL + SM_AGGA); const float* AGGH = (const float*)(ws + WS_SMALL + SM_AGGH);
    bf16* MIXED = (bf16*)(ws + WS_XN);
    LAS float* hin = (LAS float*)(F.lds);
    for (int tile = F.vcu; tile < BATCH * NCHUNK; tile += F.G) {
        const int b = tile / NCHUNK, c = tile % NCHUNK;
        __syncthreads();
        { float h = 0.f; const float* pa = AGGA + (size_t)b * NCHUNK * HW + F.tid; const float* ph = AGGH + (size_t)b * NCHUNK * HW + F.tid;
#pragma unroll 8
            for (int cc = 0; cc < c; ++cc) h = pa[(size_t)cc * HW] * h + ph[(size_t)cc * HW];
            hin[F.tid] = h; }
        __syncthreads();
        float hv[8], gl[8], gs[8];
#pragma unroll
        for (int j = 0; j < 8; ++j) { hv[j] = hin[8 * F.lane + j]; gl[j] = lrg[8 * F.lane + j]; gs[j] = sbg[8 * F.lane + j]; }
        for (int tk = F.wave; tk < 64; tk += NWAVES) { const size_t m = (size_t)b * T + c * 64 + tk;
            const f32x4 h0 = *(const f32x4*)(HLg + m * HW + 8 * F.lane), h1 = *(const f32x4*)(HLg + m * HW + 8 * F.lane + 4);
            const f32x4 p0 = *(const f32x4*)(PCg + m * HW + 8 * F.lane), p1 = *(const f32x4*)(PCg + m * HW + 8 * F.lane + 4);
            const v4u sb = *(const v4u*)(OUT_SB + m * HW + 8 * F.lane);
            float sq = 0.f; if (F.lane < 8) sq = SSQ[m * 8 + F.lane];
            float o[8]; float s2 = 0.f;
#pragma unroll
            for (int j = 0; j < 4; ++j) { o[j] = h0[j] + p0[j] * hv[j]; o[4 + j] = h1[j] + p1[j] * hv[4 + j]; }
#pragma unroll
            for (int j = 0; j < 8; ++j) s2 += o[j] * o[j];
            s2 = wave_sum(s2); sq = wave_sum(sq);
            const float rb = 1.f / sqrtf(s2 * (1.f / HW) + EPS), ra = 1.f / sqrtf(sq * (1.f / HW) + EPS);
            v4u wa, wb;
#pragma unroll
            for (int j = 0; j < 4; ++j) { const float a0 = __builtin_bit_cast(float, sb[j] << 16), a1 = __builtin_bit_cast(float, sb[j] & 0xffff0000u);
                wa[j] = pk2(a0 * ra * gs[2 * j], a1 * ra * gs[2 * j + 1]); wb[j] = pk2(o[2 * j] * rb * gl[2 * j], o[2 * j + 1] * rb * gl[2 * j + 1]); }
            *(GAS v4u*)(MIXED + m * D + 8 * F.lane) = wa; *(GAS v4u*)(MIXED + m * D + HW + 8 * F.lane) = wb; }
    }
}

__device__ __forceinline__ void p5_route(Frame& F, const float* g2w, const float* b_grp, const float* b_fine) {
    unsigned char* ws = F.ws;
    const float* H = F.out; bf16* U2 = (bf16*)(ws + WS_XN);
    const bf16* WRH = (const bf16*)(ws + WS_SMALL + SM_WRH); const bf16* WRL = (const bf16*)(ws + WS_SMALL + SM_WRL);
    int* TOKE = (int*)(ws + WS_SMALL + SM_TOKE); float* TOKW = (float*)(ws + WS_SMALL + SM_TOKW); int* HIST = (int*)(ws + WS_SMALL + SM_HIST);
    LAS int* hist = (LAS int*)(F.lds);
    for (int blk = F.vcu; blk < M / 64; blk += F.G) {
        __syncthreads();
        if (F.tid < NEXP) hist[F.tid] = 0;
        __syncthreads();
        if (F.wave < 4) {
            const int tok0 = blk * 64 + F.wave * 16, tk = F.lane & 15, q = F.lane >> 4;
            const float* hp = H + (size_t)(tok0 + tk) * D + q * 8;
            f32x4 acc[3]; float ss = 0.f;
#pragma unroll
            for (int nt = 0; nt < 3; ++nt) acc[nt] = (f32x4){0.f, 0.f, 0.f, 0.f};
#pragma unroll 4
            for (int ks = 0; ks < 32; ++ks) {
                const f32x4 a0 = *(const f32x4*)(hp + 32 * ks), a1 = *(const f32x4*)(hp + 32 * ks + 4);
                float av[8] = {a0[0], a0[1], a0[2], a0[3], a1[0], a1[1], a1[2], a1[3]};
                unsigned hh[8], ll[8];
#pragma unroll
                for (int j = 0; j < 8; ++j) { ss += av[j] * av[j]; hh[j] = f2bf(av[j]); ll[j] = f2bf(av[j] - __builtin_bit_cast(float, hh[j] << 16)); }
                v4u bh4, bl4;
#pragma unroll
                for (int j = 0; j < 4; ++j) { bh4[j] = hh[2 * j] | (hh[2 * j + 1] << 16); bl4[j] = ll[2 * j] | (ll[2 * j + 1] << 16); }
                const bf16x8 bh = __builtin_bit_cast(bf16x8, bh4), bl = __builtin_bit_cast(bf16x8, bl4);
#pragma unroll
                for (int nt = 0; nt < 3; ++nt) { const bf16x8 wh = *(const bf16x8*)(WRH + (size_t)(nt * 16 + tk) * D + 32 * ks + 8 * q), wl = *(const bf16x8*)(WRL + (size_t)(nt * 16 + tk) * D + 32 * ks + 8 * q);
                    acc[nt] = __builtin_amdgcn_mfma_f32_16x16x32_bf16(wh, bh, acc[nt], 0, 0, 0);
                    acc[nt] = __builtin_amdgcn_mfma_f32_16x16x32_bf16(wh, bl, acc[nt], 0, 0, 0);
                    acc[nt] = __builtin_amdgcn_mfma_f32_16x16x32_bf16(wl, bh, acc[nt], 0, 0, 0); }
            }
            ss += __shfl_xor(ss, 16); ss += __shfl_xor(ss, 32);
            const float ri = 1.f / sqrtf(ss * (1.f / D) + EPS);
            float gl[4]; int gi = 0;
#pragma unroll
            for (int r = 0; r < 4; ++r) gl[r] = acc[0][r] * ri + b_grp[r];
            float gm = gl[0];
#pragma unroll
            for (int r = 1; r < 4; ++r) if (gl[r] > gm) { gm = gl[r]; gi = r; }
            float gsum = 0.f;
#pragma unroll
            for (int r = 0; r < 4; ++r) gsum += __expf(gl[r] - gm);
            const float gp = 1.0f / gsum;
            float fl[8];
#pragma unroll
            for (int r = 0; r < 4; ++r) { fl[r] = acc[1][r] * ri + b_fine[8 * q + r]; fl[4 + r] = acc[2][r] * ri + b_fine[8 * q + 4 + r]; }
            int i0 = 0; float m0 = fl[0];
#pragma unroll
            for (int r = 1; r < 8; ++r) if (fl[r] > m0) { m0 = fl[r]; i0 = r; }
            int i1 = 0; float m1 = -3.0e38f;
#pragma unroll
            for (int r = 0; r < 8; ++r) if (r != i0 && fl[r] > m1) { m1 = fl[r]; i1 = r; }
            if (q == gi) { const float e1 = __expf(m1 - m0); const float p0 = 1.0f / (1.0f + e1), p1 = e1 * p0; const int tok = tok0 + tk;
                const int ea = gi * 8 + i0, eb = gi * 8 + i1;
                TOKE[tok * 2] = ea; TOKE[tok * 2 + 1] = eb; TOKW[tok * 2] = gp * p0; TOKW[tok * 2 + 1] = gp * p1;
                atomicAdd((int*)&hist[ea], 1); atomicAdd((int*)&hist[eb], 1); }
            bf16* up = U2 + (size_t)(tok0 + tk) * D + q * 8; const float* g2 = g2w + q * 8;
#pragma unroll 4
            for (int ks = 0; ks < 32; ++ks) {
                const f32x4 a0 = *(const f32x4*)(hp + 32 * ks), a1 = *(const f32x4*)(hp + 32 * ks + 4);
                const f32x4 g0 = *(const f32x4*)(g2 + 32 * ks), g1 = *(const f32x4*)(g2 + 32 * ks + 4);
                v4u o; o.x = pk2(a0[0] * ri * g0[0], a0[1] * ri * g0[1]); o.y = pk2(a0[2] * ri * g0[2], a0[3] * ri * g0[3]);
                o.z = pk2(a1[0] * ri * g1[0], a1[1] * ri * g1[1]); o.w = pk2(a1[2] * ri * g1[2], a1[3] * ri * g1[3]);
                *(GAS v4u*)(up + 32 * ks) = o; }
        }
        __syncthreads();
        if (F.tid < NEXP) HIST[blk * NEXP + F.tid] = hist[F.tid];
    }
}

__device__ __forceinline__ void p6_scatter(Frame& F) {
    unsigned char* ws = F.ws;
    const bf16* U2 = (const bf16*)(ws + WS_XN); bf16* XS = (bf16*)(ws + WS_PROJ);
    const int* TOKE = (const int*)(ws + WS_SMALL + SM_TOKE); int* TOKPOS = (int*)(ws + WS_SMALL + SM_TOKPOS); const int* HIST = (const int*)(ws + WS_SMALL + SM_HIST);
    int* TILEE = (int*)(ws + WS_SMALL + SM_TILEE);
    LAS int* ptot = (LAS int*)(F.lds); LAS int* pbel = ptot + 512; LAS int* tcnt = pbel + 512; LAS int* tbel = tcnt + 32; LAS int* off = tbel + 32; LAS int* base = off + 33; LAS int* fill = base + 32;
    for (int blk = F.vcu; blk < M / 64; blk += F.G) {
        __syncthreads();
        { const int e = F.tid & 31, part = F.tid >> 5; int tot = 0, bel = 0;
#pragma unroll 4
            for (int w = 16 * part; w < 16 * part + 16; ++w) { const int v = HIST[w * NEXP + e]; tot += v; if (w < blk) bel += v; }
            ptot[F.tid] = tot; pbel[F.tid] = bel; }
        __syncthreads();
        if (F.tid < NEXP) { int t = 0, bl = 0;
#pragma unroll
            for (int p = 0; p < 16; ++p) { t += ptot[p * 32 + F.tid]; bl += pbel[p * 32 + F.tid]; }
            tcnt[F.tid] = t; tbel[F.tid] = bl; fill[F.tid] = 0; }
        __syncthreads();
        if (F.tid == 0) { int run = 0; for (int e = 0; e < NEXP; ++e) { off[e] = run; run += (tcnt[e] + 255) & ~255; } off[NEXP] = run; }
        __syncthreads();
        if (F.tid < NEXP) base[F.tid] = off[F.tid] + tbel[F.tid];
        if (blk == 0 && F.tid < 256) { const int r0 = F.tid * 256; int e = -1;
            for (int k = 0; k < NEXP; ++k) if (off[k] <= r0 && r0 < off[k + 1]) e = k;
            TILEE[F.tid] = (F.tid == 255) ? (off[NEXP] >> 8) : (e < 0 ? 0 : e); }
        __syncthreads();
        for (int a = F.wave * 16; a < F.wave * 16 + 16; ++a) { const int tok = blk * 64 + (a >> 1), k = a & 1; const int e = TOKE[tok * 2 + k];
            int slot = 0; if (F.lane == 0) slot = atomicAdd((int*)&fill[e], 1);
            slot = __builtin_amdgcn_readfirstlane(slot); const int pos = base[e] + slot;
            if (F.lane == 0) TOKPOS[tok * 2 + k] = pos;
            const v4u* src = (const v4u*)(U2 + (size_t)tok * D); GAS v4u* dst = (GAS v4u*)(XS + (size_t)pos * D);
            dst[F.lane] = src[F.lane]; dst[64 + F.lane] = src[64 + F.lane]; }
    }
}

__device__ __forceinline__ void p9_final(Frame& F, const float* gf) {
    unsigned char* ws = F.ws;
    const bf16* YS = (const bf16*)(ws + WS_PROJ); const float* TOKW = (const float*)(ws + WS_SMALL + SM_TOKW); const int* TOKPOS = (const int*)(ws + WS_SMALL + SM_TOKPOS);
    const int gw = F.vcu * NWAVES + F.wave, NGW = F.G * NWAVES;
    for (int m = gw; m < M; m += NGW) {
        const float w0 = TOKW[m * 2], w1 = TOKW[m * 2 + 1]; const int p0 = TOKPOS[m * 2], p1 = TOKPOS[m * 2 + 1];
        float* hrow = F.out + (size_t)m * D;
        f32x4 v[4]; float s = 0.f;
#pragma unroll
        for (int j = 0; j < 4; ++j) { v[j] = *(const f32x4*)(hrow + 4 * F.lane + 256 * j);
            const unsigned long long y0 = *(const unsigned long long*)(YS + (size_t)p0 * D + 4 * F.lane + 256 * j), y1 = *(const unsigned long long*)(YS + (size_t)p1 * D + 4 * F.lane + 256 * j);
#pragma unroll
            for (int i = 0; i < 4; ++i) { const float a = __builtin_bit_cast(float, (unsigned)((y0 >> (16 * i)) & 0xffffu) << 16), c = __builtin_bit_cast(float, (unsigned)((y1 >> (16 * i)) & 0xffffu) << 16);
                v[j][i] = v[j][i] + w0 * a + w1 * c; s += v[j][i] * v[j][i]; } }
        const float ri = 1.f / sqrtf(wave_sum(s) * (1.f / D) + EPS);
#pragma unroll
        for (int j = 0; j < 4; ++j) { const f32x4 g = *(const f32x4*)(gf + 4 * F.lane + 256 * j); *(GAS f32x4*)(hrow + 4 * F.lane + 256 * j) = v[j] * ri * g; }
    }
}
constexpr int NPHASE = 10;
struct Args { const float* in[22]; float* out; unsigned char* ws; int ph_lo, ph_hi, experts, li; };
__global__ void __launch_bounds__(NWAVES * 64, 2) mk_fwd(Args args) {
    extern __shared__ __attribute__((aligned(16))) unsigned char lds[];
    Frame F;
    F.lds = (LAS unsigned char*)lds; F.MISC = (volatile LAS unsigned*)(F.lds + MISC_OFF);
    F.tid = threadIdx.x; F.lane = F.tid & 63; F.wave = __builtin_amdgcn_readfirstlane(F.tid >> 6);
    F.G = gridDim.x; { const int bx = blockIdx.x; F.vcu = (F.G % 8 == 0) ? (bx % 8) * (F.G / 8) + bx / 8 : bx; }
    F.ws = args.ws; F.out = args.out; F.ctl = (gu32*)(args.ws + WS_CTL);
    for (int u = F.tid; u < (LDS_BYTES - LDSCTL_OFF) / 4; u += NWAVES * 64) ((LAS unsigned*)(F.lds + LDSCTL_OFF))[u] = 0u;
    __syncthreads();
    const int lo = args.ph_lo, hi = args.ph_hi;
    XcdBarrier bar; bar.bar = (unsigned*)(F.ctl + CW_BAR) + args.li * XCD_BAR_WORDS; bar.x = 0; bar.st = nullptr;
    if (hi - lo > 1) bar = xcd_barrier_post((unsigned*)(F.ctl + CW_BAR) + args.li * XCD_BAR_WORDS, F.MISC + 8);
#ifndef PH_MASK
#define PH_MASK 0x3ff
#endif
#define IN(k) (((PH_MASK >> (k)) & 1) && lo <= (k) && (k) < hi)
#define BOTH(k) (IN(k) && IN((k) + 1))
#define GRID_BAR() xcd_barrier(bar)
    unsigned char* ws = args.ws;
    if (IN(0)) { p0_prologue(F, args.experts != 0, args.in[0], args.in[1], args.in[2], args.in[5], args.in[7], args.in[12], args.in[13], args.in[14], args.in[16], args.in[18], args.in[19], args.in[20]); if (BOTH(0)) GRID_BAR(); }
    if (IN(1)) {
        pg8::Gemm g{(const pg8::bf16_t*)(ws + WS_XN), (const pg8::bf16_t*)(ws + WS_WIN), M, NIN, D}; pg8::StaticOrder S; S.init(M, NIN, F.G, (int)blockIdx.x);
        pg8::EpiBf16<0> E{(pg8::bf16_t*)(ws + WS_PROJ), NIN, nullptr, 512, 512, C2};
        pg8::gemm_phase<pg8::EpiBf16<0>, pg8::StaticOrder, true, true>(F.lds, g, S, E);
        if (BOTH(1)) GRID_BAR();
    }
    if (IN(2)) { p2_mixer(F, args.in[3], args.in[4], args.in[6], args.in[8], args.in[9]); if (BOTH(2)) GRID_BAR(); }
    if (IN(3)) { p3_mixnorm(F, args.in[10], args.in[11]); if (BOTH(3)) GRID_BAR(); }
    if (IN(4)) {
        pg8::Gemm g{(const pg8::bf16_t*)(ws + WS_XN), (const pg8::bf16_t*)(ws + WS_WOUT), M, D, D}; pg8::StaticOrder S; S.init(M, D, F.G, (int)blockIdx.x);
        pg8::EpiResF32 E{args.in[0], F.out, D};
        pg8::gemm_phase<pg8::EpiResF32, pg8::StaticOrder, false, true>(F.lds, g, S, E);
        if (BOTH(4)) GRID_BAR();
    }
    if (IN(5)) { p5_route(F, args.in[13], args.in[15], args.in[17]); if (BOTH(5)) GRID_BAR(); }
    if (IN(6)) { p6_scatter(F); if (BOTH(6)) GRID_BAR(); }
    if (IN(7)) {
        LAS int* tab = (LAS int*)(F.lds + TAB_OFF);
        if (F.tid < 256) tab[F.tid] = ((const int*)(ws + WS_SMALL + SM_TILEE))[F.tid];
        __syncthreads();
        pg8::Gemm g{(const pg8::bf16_t*)(ws + WS_PROJ), (const pg8::bf16_t*)(ws + WS_WE1), XS_ROWS, NEXP * 1024, D};
        pg8::MoeOrder S{(const PG8_LAS int*)tab, tab[255] * 4, F.G, F.vcu};
        pg8::EpiGateUp E{(pg8::bf16_t*)(ws + WS_R3)};
        pg8::gemm_phase<pg8::EpiGateUp, pg8::MoeOrder, true, true>(F.lds, g, S, E);
        if (BOTH(7)) GRID_BAR();
    }
    if (IN(8)) {
        LAS int* tab = (LAS int*)(F.lds + TAB_OFF);
        if (F.tid < 256) tab[F.tid] = ((const int*)(ws + WS_SMALL + SM_TILEE))[F.tid];
        __syncthreads();
        pg8::Gemm g{(const pg8::bf16_t*)(ws + WS_R3), (const pg8::bf16_t*)(ws + WS_WE2), XS_ROWS, NEXP * 1024, DEXP};
        pg8::MoeOrder S{(const PG8_LAS int*)tab, tab[255] * 4, F.G, F.vcu};
        pg8::EpiBf16<0> E{(pg8::bf16_t*)(ws + WS_PROJ), D, nullptr, 1024, 0, 1.0f};
        pg8::gemm_phase<pg8::EpiBf16<0>, pg8::MoeOrder, true, true>(F.lds, g, S, E);
        if (BOTH(8)) GRID_BAR();
    }
    if (IN(9)) { p9_final(F, args.in[21]); }
#undef IN
#undef BOTH
#undef GRID_BAR
}
#ifndef HYB
#define HYB 4
#endif
#ifndef SPLIT_LAUNCH
#define SPLIT_LAUNCH 0
#endif
static void launch_fast(const Args& base, int lo, int hi, int grid, hipStream_t stream) {
    if (SPLIT_LAUNCH) { for (int p = lo; p < hi; ++p) { Args a = base; a.ph_lo = p; a.ph_hi = p + 1; a.li = 0; hipLaunchKernelGGL(mk_fwd, dim3(grid), dim3(NWAVES * 64), LDS_BYTES, stream, a); } }
    else { Args a = base; a.ph_lo = lo; a.ph_hi = hi; a.li = 0; hipLaunchKernelGGL(mk_fwd, dim3(grid), dim3(NWAVES * 64), LDS_BYTES, stream, a); }
    const hipError_t le = hipPeekAtLastError();
    if (le != hipSuccess) fprintf(stderr, "kernel_launch: launch failed: %s\n", hipGetErrorName(le));
}
extern "C" void kernel_launch(void* const* d_in, const int* in_sizes, int n_in, void* d_out, int out_size, void* d_ws, size_t ws_size, hipStream_t stream) {
    static int grid = 0;
    if (grid == 0) {
        if (n_in != 22 || out_size != M * D || ws_size < 266 * MiB) { fprintf(stderr, "kernel_launch: unexpected shapes (n_in %d out %d ws %zu); nothing launched\n", n_in, out_size, ws_size); grid = -1; return; }
        int dev = 0, cus = 0, per_cu = 0;
        if (hipGetDevice(&dev) != hipSuccess || hipDeviceGetAttribute(&cus, hipDeviceAttributeMultiprocessorCount, dev) != hipSuccess) { grid = -1; return; }
        if (hipFuncSetAttribute((const void*)mk_fwd, hipFuncAttributeMaxDynamicSharedMemorySize, LDS_BYTES) != hipSuccess) { fprintf(stderr, "kernel_launch: hipFuncSetAttribute failed\n"); grid = -1; return; }
        if (hipOccupancyMaxActiveBlocksPerMultiprocessor(&per_cu, (const void*)mk_fwd, NWAVES * 64, LDS_BYTES) != hipSuccess || per_cu < 1)
            fprintf(stderr, "kernel_launch: note: occupancy query reports %d workgroups per CU\n", per_cu);
        (void)hipGetLastError();
        grid = cus;
    }
    if (grid < 0) return;
    (void)hipMemsetAsync((char*)d_ws + WS_CTL, 0, CTL_ZERO_BYTES, stream);
    Args a{};
    for (int i = 0; i < 22; ++i) a.in[i] = (const float*)d_in[i];
    a.out = (float*)d_out; a.ws = (unsigned char*)d_ws; a.experts = 1; a.li = 0;
#if HYB >= 4
    launch_fast(a, 0, NPHASE, grid, stream);
#else
    using namespace nv;
    const float* x = a.in[0];
    char* ws = (char*)d_ws; float* out = (float*)d_out;
    float* RA = (float*)(ws + 1 * MiB); float* XC = (float*)(ws + 65 * MiB); float* AA = out; float* UU = out + (size_t)NM * 512;
    float* ACT = (float*)(ws + 65 * MiB); float* Y = (float*)(ws + 129 * MiB);
    int* cnt = (int*)(ws + 262 * MiB); int* eid = (int*)(ws + 262 * MiB + 4096); float* ew = (float*)(ws + 262 * MiB + 4096 + NM * 8); int* list = (int*)(ws + 263 * MiB);
    (void)hipMemsetAsync(cnt, 0, 4096, stream);
    const unsigned short* PROJB = (const unsigned short*)(ws + WS_PROJ);
#if HYB == 1
    launch_fast(a, 0, 2, grid, stream);
    k_attn<unsigned short, true><<<dim3(NS / 256, 8, NB), 256, 0, stream>>>(PROJB, RA, ND);
    k_conv<unsigned short><<<NM * 512 / 256, 256, 0, stream>>>(PROJB, a.in[3], a.in[4], XC);
    k_gate<<<NM * 512 / 256, 256, 0, stream>>>(XC, a.in[5], a.in[6], a.in[7], a.in[8], a.in[9], AA, UU);
    k_scan<unsigned short><<<16, 64, 0, stream>>>(AA, UU, PROJB, RA, ND);
    k_rms<8><<<2048, 256, 0, stream>>>(RA, ND, a.in[10], RA, ND, NM);
    k_rms<8><<<2048, 256, 0, stream>>>(RA + 512, ND, a.in[11], RA + 512, ND, NM);
    { SgP p{}; p.A = RA; p.lda = ND; p.B = a.in[12]; p.ldb = ND; p.C = out; p.ldc = ND; p.R = x; p.M = NM; p.N = ND; p.K = ND;
      k_sgemm<false, float><<<dim3(ND / 64, NM / 64, 1), 256, 0, stream>>>(p); }
#elif HYB == 2
    launch_fast(a, 0, 4, grid, stream);
    { SgP p{}; p.A = ws + WS_XN; p.lda = ND; p.B = a.in[12]; p.ldb = ND; p.C = out; p.ldc = ND; p.R = x; p.M = NM; p.N = ND; p.K = ND;
      k_sgemm<false, unsigned short><<<dim3(ND / 64, NM / 64, 1), 256, 0, stream>>>(p); }
#elif HYB == 3
    launch_fast(a, 0, 5, grid, stream);
#endif
    k_route<<<2048, 256, 0, stream>>>(out, a.in[13], a.in[14], a.in[15], a.in[16], a.in[17], RA, eid, ew, cnt, list);
    { SgP p{}; p.A = RA; p.lda = ND; p.B = a.in[18]; p.B2 = a.in[19]; p.ldb = NDE; p.C = ACT; p.ldc = NDE; p.M = NM; p.N = NDE; p.K = ND;
      p.list = list; p.cnt = cnt; p.lstride = NM; p.bstride = (long)ND * NDE; p.ashift = 1;
      k_sgemm<true, float><<<dim3(NDE / 64, NM / 64, NE), 256, 0, stream>>>(p); }
    { SgP p{}; p.A = ACT; p.lda = NDE; p.B = a.in[20]; p.ldb = ND; p.C = Y; p.ldc = ND; p.M = NM; p.N = ND; p.K = NDE;
      p.list = list; p.cnt = cnt; p.lstride = NM; p.bstride = (long)NDE * ND; p.ashift = 0;
      k_sgemm<false, float><<<dim3(ND / 64, NM / 64, NE), 256, 0, stream>>>(p); }
    k_final<<<2048, 256, 0, stream>>>(out, Y, ew, a.in[21], out);
#endif
}
```

```cpp
#define HYB 4
#define SPLIT_LAUNCH 0
#include <hip/hip_runtime.h>
#include <cstdio>
#include <cstdint>
namespace pg8 {
#define PG8_LAS __attribute__((address_space(3)))
typedef unsigned short bf16_t;
typedef short bf16x8 __attribute__((ext_vector_type(8)));
typedef float f32x4 __attribute__((ext_vector_type(4)));
typedef unsigned u32x4 __attribute__((ext_vector_type(4)));
constexpr int BM = 256, BK = 64, HALF = 128, HTB = HALF * BK * 2  , STAGE_BYTES = 8 * HTB, NXCD = 8, WGM = 8;

__host__ __device__ __forceinline__ int lds_byte(int r, int c) { const int st = (r >> 4) * 2 + (c >> 5), rr = r & 15, cc = c & 31, ob = rr * 64 + cc * 2; return st * 1024 + (ob ^ (((ob >> 9) & 1) << 5)); }
__host__ __device__ __forceinline__ void stage_rc(int b, int& R, int& C) { const int st = b / 1024, sb = b % 1024, swz = sb ^ (((sb >> 9) & 1) << 5); R = (st >> 1) * 16 + swz / 64; C = (st & 1) * 32 + (swz % 64) / 2; }
__host__ __device__ __forceinline__ int perm32(int rho) { const int n = rho >> 4, i = rho & 15; return 8 * (i >> 2) + 4 * n + (i & 3); }

struct Unit { int pm, pn; };
struct Gemm { const bf16_t* A; const bf16_t* Bt; int M, N, K; };

struct StaticOrder {
    int nM, nN, nwg, G, c;
    __host__ __device__ void init(int M, int N, int G_, int c_) { nM = M / BM; nN = N / BM; nwg = nM * nN; G = G_; c = c_; }
    __host__ __device__ bool next(int i, Unit& u) const {
        const long L = (long)i * G + c; if (L >= nwg) return false;
        int wgid = (int)L; { const int q = nwg / NXCD, r = nwg % NXCD, xcd = wgid % NXCD, off = wgid / NXCD; wgid = (xcd < r ? xcd * (q + 1) : r * (q + 1) + (xcd - r) * q) + off; }
        const int nig = WGM * nN, gid = wgid / nig, fm = gid * WGM, gsz = (nM - fm) < WGM ? (nM - fm) : WGM;
        u.pm = fm + ((wgid % nig) % gsz); u.pn = (wgid % nig) / gsz; return true;
    }
    __device__ __forceinline__ void a_ready(const Unit&) const {}
    __device__ __forceinline__ void done(const Unit&) const {}
};

__device__ __forceinline__ unsigned cvt_pk_bf16(float lo, float hi) { unsigned r; asm volatile("v_cvt_pk_bf16_f32 %0, %1, %2" : "=v"(r) : "v"(lo), "v"(hi)); return r; }
typedef float f32x2 __attribute__((ext_vector_type(2)));
__device__ __forceinline__ f32x2 gelu_pk(f32x2 v) {
    const f32x2 av = __builtin_elementwise_abs(v), d = av * 0.2316418882f + 1.0f;
    f32x2 t; t.x = __builtin_amdgcn_rcpf(d.x); t.y = __builtin_amdgcn_rcpf(d.y);
    f32x2 q = t * 0.5307027145f + (-0.7265760135f); q = q * t + 0.7107068705f; q = q * t + (-0.142248368f); q = q * t + 0.127414796f; q = q * t;
    const f32x2 s = (v * v) * (-0.72134752044f);
    f32x2 e; e.x = __builtin_amdgcn_exp2f(s.x); e.y = __builtin_amdgcn_exp2f(s.y);
    const f32x2 m = v * (q * e), r = v - m;
    f32x2 o; o.x = v.x < 0.f ? m.x : r.x; o.y = v.y < 0.f ? m.y : r.y; return o;
}

template <int ACT  > struct EpiBf16 {
    static constexpr bool PERM = true, AFTER_DRAIN = false; static_assert(ACT == 0 || ACT == 1, "EpiBf16: ACT is 0 (none) or 1 (gelu_pk)");
    bf16_t* O; int ldc; const float* bias; int split_cols; size_t split_stride; float scale0;
    __device__ __forceinline__ void operator()(const f32x4 (&acc)[2][2][4][2], const Unit& u, int wr, int wc, int fr, int fq) const {
        const int row0 = u.pm * BM + wr * 64 + fr; int colt = u.pn * BM; bf16_t* base = O;
        float sc = 1.f; if (split_cols) { const int t = colt / split_cols; base += (size_t)t * split_stride; colt -= t * split_cols; if (t == 0) sc = scale0; }
        const int col0 = colt + wc * 32 + 8 * fq, bcol0 = u.pn * BM + wc * 32 + 8 * fq;
        f32x4 bv[2][2];
#pragma unroll
        for (int bj = 0; bj < 2; ++bj)
#pragma unroll
            for (int n = 0; n < 2; ++n) bv[bj][n] = bias ? *(const f32x4*)(bias + bcol0 + bj * HALF + 4 * n) : (f32x4){0.f, 0.f, 0.f, 0.f};
#pragma unroll
        for (int ai = 0; ai < 2; ++ai)
#pragma unroll
            for (int m = 0; m < 4; ++m) { bf16_t* rowp = base + (size_t)(row0 + ai * HALF + m * 16) * ldc + col0;
#pragma unroll
                for (int bj = 0; bj < 2; ++bj) { f32x4 v0 = acc[ai][bj][m][0] + bv[bj][0], v1 = acc[ai][bj][m][1] + bv[bj][1];
                    if (ACT == 1) { f32x2 a = gelu_pk((f32x2){v0[0], v0[1]}), b = gelu_pk((f32x2){v0[2], v0[3]}), c = gelu_pk((f32x2){v1[0], v1[1]}), d = gelu_pk((f32x2){v1[2], v1[3]});
                        v0 = (f32x4){a.x, a.y, b.x, b.y}; v1 = (f32x4){c.x, c.y, d.x, d.y}; }
                    v0 = v0 * sc; v1 = v1 * sc; u32x4 w; w.x = cvt_pk_bf16(v0[0], v0[1]); w.y = cvt_pk_bf16(v0[2], v0[3]); w.z = cvt_pk_bf16(v1[0], v1[1]); w.w = cvt_pk_bf16(v1[2], v1[3]);
                    *(u32x4*)(rowp + bj * HALF) = w; } }
    }
};

struct EpiResF32 {
    static constexpr bool PERM = false, AFTER_DRAIN = false;
    const float* X; float* O; int ldc;
    __device__ __forceinline__ void operator()(const f32x4 (&acc)[2][2][4][2], const Unit& u, int wr, int wc, int fr, int fq) const {
        const int row0 = u.pm * BM + wr * 64 + fr, col0 = u.pn * BM + wc * 32 + 4 * fq;
#pragma unroll
        for (int ai = 0; ai < 2; ++ai)
#pragma unroll
            for (int m = 0; m < 4; ++m) { const size_t off = (size_t)(row0 + ai * HALF + m * 16) * ldc + col0;
#pragma unroll
                for (int bj = 0; bj < 2; ++bj)
#pragma unroll
                    for (int n = 0; n < 2; ++n) { const f32x4 xv = *(const f32x4*)(X + off + bj * HALF + n * 16); *(f32x4*)(O + off + bj * HALF + n * 16) = acc[ai][bj][m][n] + xv; } }
    }
};
struct EpiGateUp {
    static constexpr bool PERM = true, AFTER_DRAIN = false;
    bf16_t* O;
    __device__ __forceinline__ void operator()(const f32x4 (&acc)[2][2][4][2], const Unit& u, int wr, int wc, int fr, int fq) const {
        const int row0 = u.pm * BM + wr * 64 + fr, col0 = (u.pn & 3) * HALF + wc * 32 + 8 * fq;
#pragma unroll
        for (int ai = 0; ai < 2; ++ai)
#pragma unroll
            for (int m = 0; m < 4; ++m) { bf16_t* rowp = O + (size_t)(row0 + ai * HALF + m * 16) * 512 + col0;
                float v[8];
#pragma unroll
                for (int n = 0; n < 2; ++n)
#pragma unroll
                    for (int i = 0; i < 4; ++i) { const float g = acc[ai][0][m][n][i], up = acc[ai][1][m][n][i];
                        const float e = __builtin_amdgcn_exp2f(-1.4426950408889634f * g); v[n * 4 + i] = g * __builtin_amdgcn_rcpf(1.0f + e) * up; }
                u32x4 w; w.x = cvt_pk_bf16(v[0], v[1]); w.y = cvt_pk_bf16(v[2], v[3]); w.z = cvt_pk_bf16(v[4], v[5]); w.w = cvt_pk_bf16(v[6], v[7]);
                *(u32x4*)rowp = w; }
    }
};
struct MoeOrder {
    const PG8_LAS int* tile_e; int nunit, G, c;
    __device__ __forceinline__ bool next(int i, Unit& u) const {
        const long L = (long)i * G + c; if (L >= nunit) return false;
        const int pm = (int)(L >> 2); const int e = tile_e[pm]; u.pm = pm; u.pn = e * 4 + (int)(L & 3); return true;
    }
    __device__ __forceinline__ void a_ready(const Unit&) const {}
    __device__ __forceinline__ void done(const Unit&) const {}
};
template <class Epi, class Sched, bool ALIGN_EPI = false, bool SP2 = false>
__device__ __forceinline__ void gemm_phase(PG8_LAS unsigned char* lds, const Gemm g, const Sched& S, const Epi& E) {
    const int tid = threadIdx.x, wid = __builtin_amdgcn_readfirstlane(tid >> 6), lane = tid & 63, wr = wid >> 2, wc = wid & 3, fr = lane & 15, fq = lane >> 4;
    const int K = g.K, nt = K / BK;
    unsigned voffA[2], voffB[2];
#pragma unroll
    for (int i = 0; i < 2; ++i) { int R, C; stage_rc(tid * 16 + i * 8192, R, C); const int Rb = Epi::PERM ? ((R & ~31) + perm32(R & 31)) : R;
        voffA[i] = (unsigned)(R * K + C) * 2u; voffB[i] = (unsigned)(Rb * K + C) * 2u; }
    const size_t kstep = (size_t)(BK * 2);
    const size_t hstep = (size_t)HALF * K * 2;
    const size_t tstep = 2 * hstep;
    const unsigned ldsw = (unsigned)wid * 1024u;
    const int aoff = lds_byte(wr * 64 + fr, fq * 8), boff = lds_byte(wc * 32 + fr, fq * 8);
#define PG8_SA(b, h) (((b) * 2 + (h)) * HTB)
#define PG8_SB(b, h) ((4 + (b) * 2 + (h)) * HTB)
#define PG8_STAGE(bufoff, gbase, voff) do { _Pragma("unroll") for (int _i = 0; _i < 2; ++_i) \
        __builtin_amdgcn_global_load_lds((const unsigned*)((const char*)(gbase) + (voff)[_i]), (PG8_LAS unsigned*)(lds + (bufoff) + ldsw + _i * 8192), 16, 0, 0); } while (0)
#define PG8_LDA(dst, b, h) do { _Pragma("unroll") for (int m = 0; m < 4; ++m) _Pragma("unroll") for (int k = 0; k < 2; ++k) dst[m][k] = *(const PG8_LAS bf16x8*)(lds + PG8_SA(b, h) + aoff + m * 2048 + k * 1024); } while (0)
#define PG8_LDB(dst, b, h) do { _Pragma("unroll") for (int n = 0; n < 2; ++n) _Pragma("unroll") for (int k = 0; k < 2; ++k) dst[n][k] = *(const PG8_LAS bf16x8*)(lds + PG8_SB(b, h) + boff + n * 2048 + k * 1024); } while (0)
#define PG8_MMA(ai, bj, At, Bt) do { __builtin_amdgcn_s_setprio(1); _Pragma("unroll") for (int m = 0; m < 4; ++m) _Pragma("unroll") for (int n = 0; n < 2; ++n) _Pragma("unroll") for (int k = 0; k < 2; ++k) \
        acc[ai][bj][m][n] = __builtin_amdgcn_mfma_f32_16x16x32_bf16(Bt[n][k], At[m][k], acc[ai][bj][m][n], 0, 0, 0); __builtin_amdgcn_s_setprio(0); } while (0)
#define PG8_WAIT_V(n) asm volatile("s_waitcnt vmcnt(" #n ")" ::: "memory")
#define PG8_WAIT_L(n) asm volatile("s_waitcnt lgkmcnt(" #n ")" ::: "memory")
#define PG8_BAR __builtin_amdgcn_s_barrier()
#define PG8_SCHED __builtin_amdgcn_sched_barrier(0)
    Unit cur, nxt; int ui = 0;
    if (!S.next(0, cur)) return;
    f32x4 acc[2][2][4][2];
#pragma unroll
    for (int a = 0; a < 2; ++a)
#pragma unroll
        for (int b = 0; b < 2; ++b)
#pragma unroll
            for (int m = 0; m < 4; ++m)
#pragma unroll
                for (int n = 0; n < 2; ++n) acc[a][b][m][n] = (f32x4){0.f, 0.f, 0.f, 0.f};
    bf16x8 At[4][2], B0[2][2], B1[2][2];
    const char* cA = (const char*)g.A + (size_t)cur.pm * tstep; const char* cB = (const char*)g.Bt + (size_t)cur.pn * tstep;
    S.a_ready(cur);
    if constexpr (SP2) {
        PG8_STAGE(PG8_SB(0, 0), cB, voffB); PG8_STAGE(PG8_SB(0, 1), cB + hstep, voffB); PG8_STAGE(PG8_SA(0, 0), cA, voffA); PG8_STAGE(PG8_SA(0, 1), cA + hstep, voffA);
        if (wr == 1) PG8_BAR;
        PG8_WAIT_V(2); PG8_BAR;
        PG8_STAGE(PG8_SB(1, 0), cB + kstep, voffB); PG8_STAGE(PG8_SA(1, 0), cA + kstep, voffA); PG8_STAGE(PG8_SB(1, 1), cB + hstep + kstep, voffB);
        PG8_WAIT_V(6); PG8_BAR;
    } else {
        PG8_STAGE(PG8_SB(0, 0), cB, voffB); PG8_STAGE(PG8_SA(0, 0), cA, voffA); PG8_STAGE(PG8_SB(0, 1), cB + hstep, voffB); PG8_STAGE(PG8_SA(0, 1), cA + hstep, voffA);
        if (wr == 1) PG8_BAR;
        PG8_WAIT_V(4); PG8_BAR;
        PG8_STAGE(PG8_SB(1, 0), cB + kstep, voffB); PG8_STAGE(PG8_SA(1, 0), cA + kstep, voffA); PG8_STAGE(PG8_SB(1, 1), cB + hstep + kstep, voffB);
        PG8_WAIT_V(6); PG8_BAR;
    }
    for (;;) {
        const bool has_next = S.next(ui + 1, nxt);
        const char* nA = has_next ? (const char*)g.A + (size_t)nxt.pm * tstep : cA; const char* nB = has_next ? (const char*)g.Bt + (size_t)nxt.pn * tstep : cB;
        for (int t = 0; t < nt; t += 2) {
            const bool last = (t == nt - 2);
            const char* a1 = cA + (size_t)(t + 1) * kstep;
            const char* a2 = last ? nA : cA + (size_t)(t + 2) * kstep; const char* b2 = last ? nB : cB + (size_t)(t + 2) * kstep;
            const char* a3 = a2 + kstep; const char* b3 = b2 + kstep;
            if (last && has_next) S.a_ready(nxt);
            if constexpr (SP2) {
            PG8_LDB(B0, 0, 0); PG8_LDB(B1, 0, 1); PG8_SCHED; PG8_LDA(At, 0, 0); PG8_STAGE(PG8_SA(1, 1), a1 + hstep, voffA);
            PG8_WAIT_V(8); PG8_WAIT_L(0); PG8_BAR; PG8_MMA(0, 0, At, B0); PG8_MMA(0, 1, At, B1); PG8_BAR; PG8_SCHED;
            PG8_LDA(At, 0, 1); PG8_STAGE(PG8_SB(0, 0), b2, voffB); PG8_STAGE(PG8_SB(0, 1), b2 + hstep, voffB); PG8_STAGE(PG8_SA(0, 0), a2, voffA);
            PG8_WAIT_V(8); PG8_WAIT_L(0); PG8_BAR; PG8_MMA(1, 0, At, B0); PG8_MMA(1, 1, At, B1); PG8_BAR; PG8_SCHED;
            PG8_LDB(B0, 1, 0); PG8_LDB(B1, 1, 1); PG8_SCHED; PG8_LDA(At, 1, 0); PG8_STAGE(PG8_SA(0, 1), a2 + hstep, voffA);
            PG8_WAIT_V(8); PG8_WAIT_L(0); PG8_BAR; PG8_MMA(0, 0, At, B0); PG8_MMA(0, 1, At, B1); PG8_BAR; PG8_SCHED;
            PG8_LDA(At, 1, 1); PG8_STAGE(PG8_SB(1, 0), b3, voffB); PG8_STAGE(PG8_SB(1, 1), b3 + hstep, voffB); PG8_STAGE(PG8_SA(1, 0), a3, voffA);
            PG8_WAIT_V(8); PG8_WAIT_L(0); PG8_BAR; PG8_MMA(1, 0, At, B0); PG8_MMA(1, 1, At, B1); PG8_BAR; PG8_SCHED;
            } else {
            PG8_LDB(B0, 0, 0); PG8_SCHED; PG8_LDA(At, 0, 0); PG8_STAGE(PG8_SA(1, 1), a1 + hstep, voffA);
            PG8_WAIT_L(8); PG8_BAR; PG8_WAIT_L(0); PG8_MMA(0, 0, At, B0); PG8_BAR; PG8_SCHED;
            PG8_LDB(B1, 0, 1); PG8_STAGE(PG8_SB(0, 0), b2, voffB);
            PG8_BAR; PG8_WAIT_L(0); PG8_MMA(0, 1, At, B1); PG8_BAR;
            PG8_LDA(At, 0, 1); PG8_STAGE(PG8_SA(0, 0), a2, voffA);
            PG8_BAR; PG8_WAIT_L(0); PG8_MMA(1, 0, At, B0); PG8_BAR; PG8_SCHED;
            PG8_STAGE(PG8_SB(0, 1), b2 + hstep, voffB);
            PG8_WAIT_V(6); PG8_BAR; PG8_MMA(1, 1, At, B1); PG8_BAR;
            PG8_LDB(B0, 1, 0); PG8_SCHED; PG8_LDA(At, 1, 0); PG8_STAGE(PG8_SA(0, 1), a2 + hstep, voffA);
            PG8_WAIT_L(8); PG8_BAR; PG8_WAIT_L(0); PG8_MMA(0, 0, At, B0); PG8_BAR; PG8_SCHED;
            PG8_LDB(B1, 1, 1); PG8_STAGE(PG8_SB(1, 0), b3, voffB);
            PG8_BAR; PG8_WAIT_L(0); PG8_MMA(0, 1, At, B1); PG8_BAR;
            PG8_LDA(At, 1, 1); PG8_STAGE(PG8_SA(1, 0), a3, voffA);
            PG8_BAR; PG8_WAIT_L(0); PG8_MMA(1, 0, At, B0); PG8_BAR; PG8_SCHED;
            PG8_STAGE(PG8_SB(1, 1), b3 + hstep, voffB);
            PG8_WAIT_V(6); PG8_BAR; PG8_MMA(1, 1, At, B1); PG8_BAR;
            }
        }
        if constexpr (ALIGN_EPI) { if (wr == 0) PG8_BAR; }
        if constexpr (!Epi::AFTER_DRAIN) { E(acc, cur, wr, wc, fr, fq); S.done(cur); }
        if (!has_next) break;
#pragma unroll
        for (int a = 0; a < 2; ++a)
#pragma unroll
            for (int b = 0; b < 2; ++b)
#pragma unroll
                for (int m = 0; m < 4; ++m)
#pragma unroll
                    for (int n = 0; n < 2; ++n) acc[a][b][m][n] = (f32x4){0.f, 0.f, 0.f, 0.f};
        cur = nxt; cA = nA; cB = nB; ++ui;
        if constexpr (ALIGN_EPI) { if (wr == 1) PG8_BAR; }
    }
    PG8_WAIT_V(0);
    if constexpr (!ALIGN_EPI) { if (wr == 0) PG8_BAR; }
    PG8_BAR;
    if constexpr (Epi::AFTER_DRAIN) { E.fused(acc, cur, wr, wc, fr, fq, lds, wid, lane); S.done(cur); }
#undef PG8_SA
#undef PG8_SB
#undef PG8_STAGE
#undef PG8_LDA
#undef PG8_LDB
#undef PG8_MMA
#undef PG8_WAIT_V
#undef PG8_WAIT_L
#undef PG8_BAR
#undef PG8_SCHED
}
}
#define GAS __attribute__((address_space(1)))
#define LAS __attribute__((address_space(3)))
typedef unsigned short bf16;
typedef unsigned v4u __attribute__((ext_vector_type(4)));
typedef float f32x4 __attribute__((ext_vector_type(4)));
typedef short bf16x8 __attribute__((ext_vector_type(8)));
typedef GAS unsigned gu32;
typedef GAS unsigned long long gu64;
#define RLX_AGENT __ATOMIC_RELAXED, __HIP_MEMORY_SCOPE_AGENT
#define LDS_WAIT() asm volatile("s_waitcnt lgkmcnt(0)" ::: "memory")
#define VM_WAIT() asm volatile("s_waitcnt vmcnt(0)" ::: "memory")
__device__ __forceinline__ unsigned long long rt() { return __builtin_amdgcn_s_memrealtime(); }
__device__ __forceinline__ unsigned f2bf(float f) { unsigned u = __builtin_bit_cast(unsigned, f); return (u + 0x7fffu + ((u >> 16) & 1u)) >> 16; }
__device__ __forceinline__ unsigned pk2(float lo, float hi) { return f2bf(lo) | (f2bf(hi) << 16); }

#define XB_TMO      128
#define XB_XCNT(j)  (256  + 64 * (j))
#define XB_XSUB(j)  (1280 + 64 * (j))
#define XB_XGEN(j)  (2304 + 64 * (j))
#define XB_TOP      3328
#define XB_TOPGEN   3392
#define XCD_BAR_WORDS 3456
#define XB_SPIN_CAP (1u << 18)

__device__ __forceinline__ unsigned xb_ld(unsigned* p)              { return __hip_atomic_load(p, __ATOMIC_RELAXED, __HIP_MEMORY_SCOPE_AGENT); }
__device__ __forceinline__ unsigned xb_add(unsigned* p, unsigned v) { return __hip_atomic_fetch_add(p, v, __ATOMIC_RELAXED, __HIP_MEMORY_SCOPE_AGENT); }
__device__ __forceinline__ unsigned xb_xcc_id() { return (unsigned)__builtin_amdgcn_s_getreg((3 << 11) | 20) & 0xFu; }
#define XB_SPIN(cond, bar) do { unsigned _sp = 0; while (cond) { __builtin_amdgcn_s_sleep(1); \
    if ((++_sp & 255u) == 0u) { if (xb_ld(&(bar)[XB_TMO])) break; if (_sp > XB_SPIN_CAP) { atomicAdd(&(bar)[XB_TMO], 1u); break; } } } } while (0)

struct XcdBarrier {
    unsigned* bar; unsigned x;
    volatile LAS unsigned* st;
};

__device__ __forceinline__ XcdBarrier xcd_barrier_post(unsigned* bar, volatile LAS unsigned* st) {
    XcdBarrier b; b.bar = bar; b.x = xb_xcc_id(); b.st = st;
    if (threadIdx.x == 0) (void)xb_add(&bar[XB_XCNT(b.x)], 1u);
    return b;
}
__device__ __forceinline__ void xcd_barrier_complete(unsigned* bar, unsigned x, unsigned& nloc, unsigned& nx) {
    const unsigned G = gridDim.x * gridDim.y * gridDim.z;
    unsigned sum, cnt, mine, sp = 0u;
    for (;;) {
        sum = 0u; cnt = 0u; mine = 0u;
#pragma unroll
        for (unsigned j = 0; j < 16; ++j) { const unsigned c = xb_ld(&bar[XB_XCNT(j)]); sum += c; cnt += (c > 0u) ? 1u : 0u; mine = (j == x) ? c : mine; }
        if (sum == G) break;
        __builtin_amdgcn_s_sleep(1);
        if ((++sp & 255u) == 0u) { if (xb_ld(&bar[XB_TMO])) break; if (sp > XB_SPIN_CAP) { atomicAdd(&bar[XB_TMO], 1u); break; } }
    }
    nloc = mine > 0u ? mine : 1u; nx = cnt > 0u ? cnt : 1u;
}

__device__ __forceinline__ void xcd_barrier(const XcdBarrier& b) {
    asm volatile("s_waitcnt vmcnt(0)" ::: "memory");
    __syncthreads();
    if (threadIdx.x == 0) {
        unsigned* bar = b.bar;
        __builtin_amdgcn_s_waitcnt(0);
        unsigned nloc = b.st[0], nx = b.st[1];
        if (nloc == 0u) { xcd_barrier_complete(bar, b.x, nloc, nx); b.st[0] = nloc; b.st[1] = nx; }
        const unsigned old = xb_add(&bar[XB_XSUB(b.x)], 1u);
        const unsigned gen = old / nloc;
        if (old + 1u == (gen + 1u) * nloc) {
            __builtin_amdgcn_fence(__ATOMIC_RELEASE, "agent");
            asm volatile("s_waitcnt vmcnt(0)" ::: "memory");
            const unsigned og = xb_add(&bar[XB_TOP], 1u);
            const unsigned tg = og / nx;
            if (og + 1u == (tg + 1u) * nx) xb_add(&bar[XB_TOPGEN], 1u);
            else XB_SPIN(xb_ld(&bar[XB_TOPGEN]) == tg, bar);
            __builtin_amdgcn_fence(__ATOMIC_ACQUIRE, "agent");
            xb_add(&bar[XB_XGEN(b.x)], 1u);
            asm volatile("s_waitcnt vmcnt(0)" ::: "memory");
        } else {
            XB_SPIN(xb_ld(&bar[XB_XGEN(b.x)]) == gen, bar);
            __builtin_amdgcn_fence(__ATOMIC_ACQUIRE, "agent");
            asm volatile("s_waitcnt vmcnt(0)" ::: "memory");
        }
    }
    __syncthreads();
}

constexpr int NWAVES = 8;
constexpr int BATCH = 2, T = 8192, D = 1024, M = BATCH * T, NIN = 2560, HW = 512, NEXP = 32, DEXP = 512;
constexpr float EPS = 1e-6f, LOG2E = 1.4426950408889634f, C2 = 0.125f * LOG2E;
constexpr int XS_ROWS = 32768 + NEXP * 256;
constexpr int NCHUNK = T / 64;
constexpr size_t MiB = 1u << 20;
constexpr size_t WS_CTL = 0, CTL_ZERO_BYTES = 1 * MiB;
constexpr size_t WS_WIN = 1 * MiB, WS_WOUT = 6 * MiB, WS_WE1 = 8 * MiB, WS_WE2 = 72 * MiB, WS_SMALL = 104 * MiB;
constexpr size_t WS_XN = 108 * MiB;
constexpr size_t WS_PROJ = 140 * MiB;
constexpr size_t WS_R3 = 220 * MiB;
constexpr size_t WS_END = 260 * MiB;
constexpr size_t SM_WGT = 0, SM_WRH = 131072, SM_WRL = 229376, SM_SSQ = 327680, SM_AGGA = 851968, SM_AGGH = 1376256, SM_TOKE = 1900544, SM_TOKW = 2031616,
                 SM_TOKPOS = 2162688, SM_HIST = 2293760, SM_TILEE = 2326528;
constexpr int CW_TMO = 0, CW_CODE = 1, CW_BAR = 4096;
constexpr int RING_BYTES = 131072, LDSCTL_OFF = RING_BYTES, MISC_OFF = LDSCTL_OFF + 320, TAB_OFF = LDSCTL_OFF + 1024, LDS_BYTES = 147456;
constexpr int WAVE_LDS = 14336;

struct Frame {
    LAS unsigned char* lds; volatile LAS unsigned* MISC; gu32* ctl;
    int tid, lane, wave, vcu, G;
    float* out; unsigned char* ws;
};
__device__ __forceinline__ float wave_sum(float v) {
#pragma unroll
    for (int o = 1; o < 64; o <<= 1) v += __shfl_xor(v, o);
    return v;
}
__device__ __forceinline__ float bf2f(unsigned short v) { return __builtin_bit_cast(float, (unsigned)v << 16); }
typedef float f32x2_t __attribute__((ext_vector_type(2))); typedef __bf16 bf16x2_t __attribute__((ext_vector_type(2)));
__device__ __forceinline__ unsigned cvtpk(float lo, float hi) { f32x2_t v = {lo, hi}; bf16x2_t b = __builtin_convertvector(v, bf16x2_t); return __builtin_bit_cast(unsigned, b); }
typedef float f32x16 __attribute__((ext_vector_type(16)));
typedef short s16x4 __attribute__((ext_vector_type(4)));
__device__ __forceinline__ int crow(int r, int hi) { return (r & 3) + 8 * (r >> 2) + 4 * hi; }
#define CBAR() asm volatile("" ::: "memory")

__device__ __forceinline__ void tr_item(const float* W, int N, int k0, int n0, bf16* dst, int Kd, LAS float* scr, int lane) {
#pragma unroll 8
    for (int i = 0; i < 32; ++i) { const int kk = 2 * i + (lane >> 5); scr[kk * 33 + (lane & 31)] = W[(size_t)(k0 + kk) * N + n0 + (lane & 31)]; }
    LDS_WAIT(); CBAR();
    const int c = lane & 7;
#pragma unroll
    for (int j = 0; j < 4; ++j) { const int n = (lane >> 3) + 8 * j; const LAS float* s = scr + (8 * c) * 33 + n;
        v4u o; o.x = pk2(s[0 * 33], s[1 * 33]); o.y = pk2(s[2 * 33], s[3 * 33]); o.z = pk2(s[4 * 33], s[5 * 33]); o.w = pk2(s[6 * 33], s[7 * 33]);
        *(GAS v4u*)(dst + (size_t)n * Kd + k0 + 8 * c) = o; }
    LDS_WAIT(); CBAR();
}
__device__ __forceinline__ void rms_row_to_bf16(const float* xrow, const float* g, bf16* orow, int lane) {
    const GAS f32x4* xr = (const GAS f32x4*)xrow + lane; const GAS f32x4* gr = (const GAS f32x4*)g + lane;
    f32x4 v[4]; float s = 0.f;
#pragma unroll
    for (int j = 0; j < 4; ++j) { v[j] = xr[64 * j]; s += (v[j].x * v[j].x + v[j].y * v[j].y) + (v[j].z * v[j].z + v[j].w * v[j].w); }
    const float ri = 1.f / sqrtf(wave_sum(s) * (1.f / D) + EPS);
    GAS unsigned long long* o8 = (GAS unsigned long long*)orow + lane;
#pragma unroll
    for (int j = 0; j < 4; ++j) { const f32x4 gg = gr[64 * j];
        o8[64 * j] = (unsigned long long)pk2(v[j].x * ri * gg.x, v[j].y * ri * gg.y) | ((unsigned long long)pk2(v[j].z * ri * gg.z, v[j].w * ri * gg.w) << 32); }
}
__device__ __forceinline__ void p0_prologue(Frame& F, bool experts, const float* x, const float* g1, const float* w_in, const float* w_r, const float* w_i, const float* w_out,
        const float* g2, const float* w_grp, const float* w_fine, const float* w_eg, const float* w_eu, const float* w_ed) {
    LAS float* scr = (LAS float*)(F.lds + F.wave * 16384);
    const int gw = F.vcu * NWAVES + F.wave, NGW = F.G * NWAVES;
    unsigned char* ws = F.ws;
    bf16* WIN_T = (bf16*)(ws + WS_WIN); bf16* WOUT_T = (bf16*)(ws + WS_WOUT); bf16* WE1_T = (bf16*)(ws + WS_WE1); bf16* WE2_T = (bf16*)(ws + WS_WE2);
    constexpr int I_IN = 16 * 80, I_OUT = 16 * 32, I_GU = 16 * 16, I_DN = 8 * 32;
    const int NITEMS = I_IN + I_OUT + (experts ? NEXP * (2 * I_GU + I_DN) : 0);
    for (int it = gw; it < NITEMS; it += NGW) {
        int r = it;
        if (r < I_IN) { const int kb = r / 80, nb = r % 80; tr_item(w_in, NIN, 64 * kb, 32 * nb, WIN_T + (size_t)(32 * nb) * D, D, scr, F.lane); continue; } r -= I_IN;
        if (r < I_OUT) { const int kb = r / 32, nb = r % 32; tr_item(w_out, D, 64 * kb, 32 * nb, WOUT_T + (size_t)(32 * nb) * D, D, scr, F.lane); continue; } r -= I_OUT;
        if (r < NEXP * 2 * I_GU) { const int e = r / (2 * I_GU), rr = r % (2 * I_GU), mat = rr / I_GU, q = rr % I_GU, kb = q / 16, nb = q % 16, n0 = 32 * nb;
            const float* src = (mat ? w_eu : w_eg) + (size_t)e * D * DEXP; const int drow = 256 * (n0 >> 7) + (n0 & 127) + 128 * mat;
            tr_item(src, DEXP, 64 * kb, n0, WE1_T + ((size_t)e * 1024 + drow) * D, D, scr, F.lane); continue; } r -= NEXP * 2 * I_GU;
        { const int e = r / I_DN, q = r % I_DN, kb = q / 32, nb = q % 32;
            tr_item(w_ed + (size_t)e * DEXP * D, D, 64 * kb, 32 * nb, WE2_T + ((size_t)e * 1024 + 32 * nb) * DEXP, DEXP, scr, F.lane); }
    }
    bf16* XN = (bf16*)(ws + WS_XN);
    for (int m = gw; m < M; m += NGW) rms_row_to_bf16(x + (size_t)m * D, g1, XN + (size_t)m * D, F.lane);
    const int gt = gw * 64 + F.lane, NT = NGW * 64;
    bf16* WGT = (bf16*)(ws + WS_SMALL + SM_WGT);
    for (int i = gt; i < 2 * 8 * 64 * 64; i += NT) { const int gate = i >> 15, n = (i >> 12) & 7, d = (i >> 6) & 63, c = i & 63;
        WGT[i] = (bf16)f2bf((gate ? w_i : w_r)[(n * 64 + c) * 64 + d]); }
    bf16* WRH = (bf16*)(ws + WS_SMALL + SM_WRH); bf16* WRL = (bf16*)(ws + WS_SMALL + SM_WRL);
    for (int i = gt; i < 48 * 1024; i += NT) { const int rho = i >> 10, k = i & 1023; float w;
        if (rho < 16) w = w_grp[k * 4 + (rho & 3)];
        else { const int nt = rho >> 4, q = (rho >> 2) & 3, reg = rho & 3; w = w_fine[k * 32 + 8 * q + (nt == 2 ? 4 : 0) + reg]; }
        const float val = g2[k] * w; const unsigned h = f2bf(val); const float hf = __builtin_bit_cast(float, h << 16);
        WRH[i] = (bf16)h; WRL[i] = (bf16)f2bf(val - hf); }
}

__device__ __forceinline__ s16x4 vtr(const LAS char* p) { typedef short v4i16_t __attribute__((ext_vector_type(4)));
    return __builtin_bit_cast(s16x4, __builtin_amdgcn_ds_read_tr16_b64_v4i16((LAS v4i16_t*)p)); }
__device__ __forceinline__ void sb_item(const bf16* __restrict__ proj, bf16* out_sb, float* ssq, int b, int h, int qt, LAS char* wl, int lane) {
    const int r32 = lane & 31, hi = lane >> 5;
    const size_t rowbase = (size_t)b * T; const int t0 = qt * 32;
    const bf16* Qp = proj + (rowbase + t0 + r32) * NIN + h * 64 + hi * 8;
    bf16x8 qr[4];
#pragma unroll
    for (int d0 = 0; d0 < 4; ++d0) qr[d0] = *(const bf16x8*)(Qp + d0 * 16);
    const bf16* Kb = proj + rowbase * NIN + 512 + h * 64 + hi * 8;
    const bf16* Vb = proj + rowbase * NIN + 1024 + h * 64 + (lane & 3) * 8;
    f32x16 o0, o1;
#pragma unroll
    for (int r = 0; r < 16; ++r) { o0[r] = 0.f; o1[r] = 0.f; }
    float C = 1.0f;
    bf16x8 kc[4]; v4u vc[4];
#pragma unroll
    for (int d0 = 0; d0 < 4; ++d0) kc[d0] = *(const bf16x8*)(Kb + (size_t)(t0 + r32) * NIN + d0 * 16);
#pragma unroll
    for (int p = 0; p < 4; ++p) vc[p] = *(const v4u*)(Vb + (size_t)(t0 + (p & 1) * 16 + (lane >> 2)) * NIN + (p >> 1) * 32);
    const LAS char* vp0 = wl + ((lane >> 4) & 1) * 32 + (lane & 3) * 8 + (4 * hi + ((lane & 15) >> 2)) * 64;
    int buf = 0;
    for (int k0 = t0;; k0 -= 32) {
        const int kn0 = k0 >= 32 ? k0 - 32 : 0;
        bf16x8 kn[4]; v4u vn[4];
#pragma unroll
        for (int d0 = 0; d0 < 4; ++d0) kn[d0] = *(const bf16x8*)(Kb + (size_t)(kn0 + r32) * NIN + d0 * 16);
#pragma unroll
        for (int p = 0; p < 4; ++p) vn[p] = *(const v4u*)(Vb + (size_t)(kn0 + (p & 1) * 16 + (lane >> 2)) * NIN + (p >> 1) * 32);
        LAS char* vimg = wl + buf * 4096;
#pragma unroll
        for (int p = 0; p < 4; ++p) *(LAS v4u*)(vimg + p * 1024 + lane * 16) = vc[p];
        f32x16 p;
#pragma unroll
        for (int r = 0; r < 16; ++r) p[r] = 0.f;
#pragma unroll
        for (int d0 = 0; d0 < 4; ++d0) p = __builtin_amdgcn_mfma_f32_32x32x16_bf16(kc[d0], qr[d0], p, 0, 0, 0);
        float nb[16];
#pragma unroll
        for (int r = 0; r < 16; ++r) { const float e = __builtin_amdgcn_exp2f(p[r]); nb[r] = __builtin_amdgcn_rcpf(1.0f + e); }
        if (k0 == t0) {
#pragma unroll
            for (int r = 0; r < 16; ++r) if (crow(r, hi) >= r32) nb[r] = 1.0f;
        }
        float G[4], PG[4];
#pragma unroll
        for (int g = 0; g < 4; ++g) G[g] = (nb[4 * g] * nb[4 * g + 1]) * (nb[4 * g + 2] * nb[4 * g + 3]);
#pragma unroll
        for (int g = 0; g < 4; ++g) { const unsigned gu = __builtin_bit_cast(unsigned, G[g]); auto rr = __builtin_amdgcn_permlane32_swap(gu, gu, false, false);
            PG[g] = __builtin_bit_cast(float, hi ? rr[0] : rr[1]); }
        float Sg[4]; Sg[3] = C;
#pragma unroll
        for (int g = 3; g > 0; --g) Sg[g - 1] = Sg[g] * (G[g] * PG[g]);
        const float Cn = Sg[0] * (G[0] * PG[0]);
        float w[16];
#pragma unroll
        for (int g = 0; g < 4; ++g) { float E = hi ? Sg[g] : Sg[g] * PG[g];
#pragma unroll
            for (int m = 3; m >= 0; --m) { const float En = E * nb[4 * g + m]; w[4 * g + m] = E - En; E = En; } }
        C = Cn;
        v4u pw0, pw1;
        pw0.x = cvtpk(w[0], w[1]); pw0.y = cvtpk(w[2], w[3]); pw0.z = cvtpk(w[4], w[5]); pw0.w = cvtpk(w[6], w[7]);
        pw1.x = cvtpk(w[8], w[9]); pw1.y = cvtpk(w[10], w[11]); pw1.z = cvtpk(w[12], w[13]); pw1.w = cvtpk(w[14], w[15]);
        CBAR();
        const LAS char* vp = vp0 + buf * 4096;
        s16x4 vl[4], vh[4];
#pragma unroll
        for (int i = 0; i < 4; ++i) { vl[i] = vtr(vp + (i >> 1) * 2048 + (i & 1) * 1024); vh[i] = vtr(vp + (i >> 1) * 2048 + (i & 1) * 1024 + 512); }
#define VFR(i) (bf16x8){vl[i][0], vl[i][1], vl[i][2], vl[i][3], vh[i][0], vh[i][1], vh[i][2], vh[i][3]}
        o0 = __builtin_amdgcn_mfma_f32_32x32x16_bf16(__builtin_bit_cast(bf16x8, pw0), VFR(0), o0, 0, 0, 0);
        o0 = __builtin_amdgcn_mfma_f32_32x32x16_bf16(__builtin_bit_cast(bf16x8, pw1), VFR(1), o0, 0, 0, 0);
        o1 = __builtin_amdgcn_mfma_f32_32x32x16_bf16(__builtin_bit_cast(bf16x8, pw0), VFR(2), o1, 0, 0, 0);
        o1 = __builtin_amdgcn_mfma_f32_32x32x16_bf16(__builtin_bit_cast(bf16x8, pw1), VFR(3), o1, 0, 0, 0);
#undef VFR
        CBAR();
        if (k0 == 0) break;
        if (__all(C == 0.0f)) break;
#pragma unroll
        for (int d0 = 0; d0 < 4; ++d0) kc[d0] = kn[d0];
#pragma unroll
        for (int pp = 0; pp < 4; ++pp) vc[pp] = vn[pp];
        buf ^= 1;
    }
    LAS unsigned short* stg = (LAS unsigned short*)(wl + 8192);
#pragma unroll
    for (int r = 0; r < 16; ++r) { const int orow = crow(r, hi);
        stg[orow * 64 + r32] = (unsigned short)f2bf(o0[r]); stg[orow * 64 + 32 + r32] = (unsigned short)f2bf(o1[r]); }
    CBAR(); LDS_WAIT(); CBAR();
#pragma unroll
    for (int i = 0; i < 4; ++i) { const int row = i * 8 + (lane >> 3), ch = lane & 7;
        const v4u v = *(const LAS v4u*)(stg + row * 64 + ch * 8);
        *(GAS v4u*)(out_sb + (rowbase + t0 + row) * HW + h * 64 + ch * 8) = v;
        float s = 0.f;
#pragma unroll
        for (int j = 0; j < 4; ++j) { const float a = __builtin_bit_cast(float, v[j] << 16), c = __builtin_bit_cast(float, v[j] & 0xffff0000u); s += a * a + c * c; }
        s += __shfl_xor(s, 1); s += __shfl_xor(s, 2); s += __shfl_xor(s, 4);
        if (ch == 0) ssq[(rowbase + t0 + row) * 8 + h] = s; }
    CBAR(); LDS_WAIT(); CBAR();
}

__device__ __forceinline__ void lru_unit(const bf16* __restrict__ proj, const bf16* __restrict__ wgt, const float* conv_w, const float* conv_b, const float* b_r, const float* b_i,
                                         const float* lam, float* HLg, float* PCg, float* AGGA, float* AGGH, int b, int c, int n, LAS char* wl, int lane) {
    const int r32 = lane & 31, hi = lane >> 5;
    float Pa = 1.0f, Ha = 0.0f, Pb = 1.0f, Hb = 0.0f;
    LAS char* XT = wl; LAS char* GT = wl + 4608; LAS char* XCT = wl + 8704;
    for (int tile = 0; tile < 2; ++tile) {
        const int tt0 = c * 64 + tile * 32; const size_t m0 = (size_t)b * T + tt0;
#pragma unroll
        for (int q0 = 0; q0 < 320; q0 += 64) { const int q = q0 + lane; if (q < 280) { const int row = q >> 3, chunk = q & 7; v4u v = {0u, 0u, 0u, 0u};
                if (tt0 - 3 + row >= 0) v = *(const v4u*)(proj + (m0 + row - 3) * NIN + 1536 + n * 64 + chunk * 8);
                *(LAS v4u*)(XT + row * 128 + chunk * 16) = v; } }
#pragma unroll
        for (int q0 = 0; q0 < 256; q0 += 64) { const int q = q0 + lane; const int row = q >> 3, chunk = q & 7;
            *(LAS v4u*)(GT + row * 128 + chunk * 16) = *(const v4u*)(proj + (m0 + row) * NIN + 2048 + n * 64 + chunk * 8); }
        CBAR(); LDS_WAIT(); CBAR();
#pragma unroll 1
        for (int nh = 0; nh < 2; ++nh) { const int ch = n * 64 + nh * 32 + r32;
            const float c0 = conv_w[ch], c1 = conv_w[HW + ch], c2 = conv_w[2 * HW + ch], c3 = conv_w[3 * HW + ch], cb = conv_b[ch];
#pragma unroll
            for (int g = 0; g < 4; ++g) { const int tau0 = 8 * g + 4 * hi; float xs[7];
#pragma unroll
                for (int i = 0; i < 7; ++i) xs[i] = bf2f(*(const LAS unsigned short*)(XT + (tau0 + i) * 128 + (nh * 32 + r32) * 2));
#pragma unroll
                for (int m = 0; m < 4; ++m) { const float v = cb + ((c0 * xs[m] + c1 * xs[m + 1]) + (c2 * xs[m + 2] + c3 * xs[m + 3]));
                    *(LAS unsigned short*)(XCT + (tau0 + m) * 144 + (nh * 32 + r32) * 2) = (unsigned short)f2bf(v); } } }
        CBAR(); LDS_WAIT(); CBAR();
        bf16x8 xa[4];
#pragma unroll
        for (int ks = 0; ks < 4; ++ks) xa[ks] = *(const LAS bf16x8*)(XCT + r32 * 144 + ks * 32 + hi * 16);
#pragma unroll 1
        for (int nh = 0; nh < 2; ++nh) { const int ch = n * 64 + nh * 32 + r32;
            const float br = b_r[ch], bi = b_i[ch]; const float l = lam[ch];
            const float clam = 8.0f * LOG2E * (fminf(l, 0.f) - log1pf(__expf(-fabsf(l))));
            f32x16 ar, ai;
#pragma unroll
            for (int r = 0; r < 16; ++r) { ar[r] = 0.f; ai[r] = 0.f; }
            const bf16* wrp = wgt + ((size_t)(0 * 8 + n) * 64 + nh * 32 + r32) * 64 + hi * 8;
            const bf16* wip = wgt + ((size_t)(1 * 8 + n) * 64 + nh * 32 + r32) * 64 + hi * 8;
#pragma unroll
            for (int ks = 0; ks < 4; ++ks) { const bf16x8 wr8 = *(const bf16x8*)(wrp + ks * 16), wi8 = *(const bf16x8*)(wip + ks * 16);
                ar = __builtin_amdgcn_mfma_f32_32x32x16_bf16(xa[ks], wr8, ar, 0, 0, 0); ai = __builtin_amdgcn_mfma_f32_32x32x16_bf16(xa[ks], wi8, ai, 0, 0, 0); }
            float a[16], u[16];
#pragma unroll
            for (int r = 0; r < 16; ++r) {
                const float xc = bf2f(*(const LAS unsigned short*)(XCT + crow(r, hi) * 144 + (nh * 32 + r32) * 2));
                const float rg = __builtin_amdgcn_rcpf(1.0f + __builtin_amdgcn_exp2f(-LOG2E * (ar[r] + br)));
                const float ig = __builtin_amdgcn_rcpf(1.0f + __builtin_amdgcn_exp2f(-LOG2E * (ai[r] + bi)));
                const float av = __builtin_amdgcn_exp2f(rg * clam);
                a[r] = av; u[r] = __builtin_amdgcn_sqrtf(fmaxf(1.0f - av * av, 0.0f)) * (ig * xc); }
            float Ag[4], Bg[4], PAg[4], PBg[4];
#pragma unroll
            for (int g = 0; g < 4; ++g) { float A = a[4 * g], Bv = u[4 * g];
#pragma unroll
                for (int m = 1; m < 4; ++m) { A *= a[4 * g + m]; Bv = Bv * a[4 * g + m] + u[4 * g + m]; }
                Ag[g] = A; Bg[g] = Bv; }
#pragma unroll
            for (int g = 0; g < 4; ++g) { const unsigned ua = __builtin_bit_cast(unsigned, Ag[g]), ub = __builtin_bit_cast(unsigned, Bg[g]);
                auto ra = __builtin_amdgcn_permlane32_swap(ua, ua, false, false); auto rb = __builtin_amdgcn_permlane32_swap(ub, ub, false, false);
                PAg[g] = __builtin_bit_cast(float, hi ? ra[0] : ra[1]); PBg[g] = __builtin_bit_cast(float, hi ? rb[0] : rb[1]); }
            float P = nh ? Pb : Pa, H = nh ? Hb : Ha; float P0[4], H0[4];
#pragma unroll
            for (int g = 0; g < 4; ++g) {
                const float Alo = hi ? PAg[g] : Ag[g], Blo = hi ? PBg[g] : Bg[g], Ahi = hi ? Ag[g] : PAg[g], Bhi = hi ? Bg[g] : PBg[g];
                const float P1 = P * Alo, H1 = Alo * H + Blo;
                P0[g] = hi ? P1 : P; H0[g] = hi ? H1 : H;
                P = P1 * Ahi; H = Ahi * H1 + Bhi; }
            if (nh) { Pb = P; Hb = H; } else { Pa = P; Ha = H; }
            float* hl = HLg + n * 64 + nh * 32 + r32; float* pc = PCg + n * 64 + nh * 32 + r32;
#pragma unroll
            for (int g = 0; g < 4; ++g) { float Pv = P0[g], Hv = H0[g];
#pragma unroll
                for (int m = 0; m < 4; ++m) { const int r = 4 * g + m; Pv *= a[r]; Hv = a[r] * Hv + u[r];
                    const int tau = 8 * g + 4 * hi + m;
                    const float gv = bf2f(*(const LAS unsigned short*)(GT + tau * 128 + (nh * 32 + r32) * 2));
                    const float ge = gv * __builtin_amdgcn_rcpf(1.0f + __builtin_amdgcn_exp2f(-2.0f * LOG2E * 0.7978845608028654f * (gv + 0.044715f * gv * gv * gv)));
                    hl[(m0 + tau) * HW] = Hv * ge; pc[(m0 + tau) * HW] = Pv * ge; } }
        }
        CBAR(); LDS_WAIT(); CBAR();
    }
    if (hi == 0) { const size_t o = ((size_t)b * NCHUNK + c) * HW + n * 64 + r32; AGGA[o] = Pa; AGGH[o] = Ha; AGGA[o + 32] = Pb; AGGH[o + 32] = Hb; }
}
__device__ __forceinline__ void p2_mixer(Frame& F, const float* conv_w, const float* conv_b, const float* b_r, const float* b_i, const float* lam) {
    unsigned char* ws = F.ws;
    const bf16* PROJ = (const bf16*)(ws + WS_PROJ); const bf16* WGT = (const bf16*)(ws + WS_SMALL + SM_WGT);
    bf16* OUT_SB = (bf16*)(ws + WS_R3); float* SSQ = (float*)(ws + WS_SMALL + SM_SSQ);
    float* HLg = F.out; float* PCg = F.out + (size_t)M * HW;
    float* AGGA = (float*)(ws + WS_SMALL + SM_AGGA); float* AGGH = (float*)(ws + WS_SMALL + SM_AGGH);
    LAS char* wl = (LAS char*)(F.lds + F.wave * WAVE_LDS);
    const int gw = F.vcu * NWAVES + F.wave, NGW = F.G * NWAVES;
#ifndef NO_LRU
    for (int L = gw; L < BATCH * NCHUNK * 8; L += NGW) { const int n = L & 7, c = (L >> 3) & (NCHUNK - 1), b = L >> 10;
        lru_unit(PROJ, WGT, conv_w, conv_b, b_r, b_i, lam, HLg, PCg, AGGA, AGGH, b, c, n, wl, F.lane); }
#endif
#ifndef NO_SB
    for (int i = gw; i < BATCH * 8 * (T / 32); i += NGW) { const int qt = i & 255, bh = i >> 8;
        sb_item(PROJ, OUT_SB, SSQ, bh >> 3, bh & 7, qt, wl, F.lane); }
#endif
}

__device__ __forceinline__ void p3_mixnorm(Frame& F, const float* sbg, const float* lrg) {
    unsigned char* ws = F.ws;
    const bf16* OUT_SB = (const bf16*)(ws + WS_R3); const float* SSQ = (const float*)(ws + WS_SMALL + SM_SSQ);
    const float* HLg = F.out; const float* PCg = F.out + (size_t)M * HW;
    const float* AGGA = (const float*)(ws + WS_SMALL + SM_AGGA); const float* AGGH = (const float*)(ws + WS_SMALL + SM_AGGH);
    bf16* MIXED = (bf16*)(ws + WS_XN);
    LAS float* hin = (LAS float*)(F.lds);
    for (int tile = F.vcu; tile < BATCH * NCHUNK; tile += F.G) {
        const int b = tile / NCHUNK, c = tile % NCHUNK;
        __syncthreads();
        { float h = 0.f; const float* pa = AGGA + (size_t)b * NCHUNK * HW + F.tid; const float* ph = AGGH + (size_t)b * NCHUNK * HW + F.tid;
#pragma unroll 8
            for (int cc = 0; cc < c; ++cc) h = pa[(size_t)cc * HW] * h + ph[(size_t)cc * HW];
            hin[F.tid] = h; }
        __syncthreads();
        float hv[8], gl[8], gs[8];
#pragma unroll
        for (int j = 0; j < 8; ++j) { hv[j] = hin[8 * F.lane + j]; gl[j] = lrg[8 * F.lane + j]; gs[j] = sbg[8 * F.lane + j]; }
        for (int tk = F.wave; tk < 64; tk += NWAVES) { const size_t m = (size_t)b * T + c * 64 + tk;
            const f32x4 h0 = *(const f32x4*)(HLg + m * HW + 8 * F.lane), h1 = *(const f32x4*)(HLg + m * HW + 8 * F.lane + 4);
            const f32x4 p0 = *(const f32x4*)(PCg + m * HW + 8 * F.lane), p1 = *(const f32x4*)(PCg + m * HW + 8 * F.lane + 4);
            const v4u sb = *(const v4u*)(OUT_SB + m * HW + 8 * F.lane);
            float sq = 0.f; if (F.lane < 8) sq = SSQ[m * 8 + F.lane];
            float o[8]; float s2 = 0.f;
#pragma unroll
            for (int j = 0; j < 4; ++j) { o[j] = h0[j] + p0[j] * hv[j]; o[4 + j] = h1[j] + p1[j] * hv[4 + j]; }
#pragma unroll
            for (int j = 0; j < 8; ++j) s2 += o[j] * o[j];
            s2 = wave_sum(s2); sq = wave_sum(sq);
            const float rb = 1.f / sqrtf(s2 * (1.f / HW) + EPS), ra = 1.f / sqrtf(sq * (1.f / HW) + EPS);
            v4u wa, wb;
#pragma unroll
            for (int j = 0; j < 4; ++j) { const float a0 = __builtin_bit_cast(float, sb[j] << 16), a1 = __builtin_bit_cast(float, sb[j] & 0xffff0000u);
                wa[j] = pk2(a0 * ra * gs[2 * j], a1 * ra * gs[2 * j + 1]); wb[j] = pk2(o[2 * j] * rb * gl[2 * j], o[2 * j + 1] * rb * gl[2 * j + 1]); }
            *(GAS v4u*)(MIXED + m * D + 8 * F.lane) = wa; *(GAS v4u*)(MIXED + m * D + HW + 8 * F.lane) = wb; }
    }
}

__device__ __forceinline__ void p5_route(Frame& F, const float* g2w, const float* b_grp, const float* b_fine) {
    unsigned char* ws = F.ws;
    const float* H = F.out; bf16* U2 = (bf16*)(ws + WS_XN);
    const bf16* WRH = (const bf16*)(ws + WS_SMALL + SM_WRH); const bf16* WRL = (const bf16*)(ws + WS_SMALL + SM_WRL);
    int* TOKE = (int*)(ws + WS_SMALL + SM_TOKE); float* TOKW = (float*)(ws + WS_SMALL + SM_TOKW); int* HIST = (int*)(ws + WS_SMALL + SM_HIST);
    LAS float* red = (LAS float*)(F.lds);
    LAS int* hist = (LAS int*)(F.lds + 110592); LAS float* rinvs = (LAS float*)(F.lds + 110592 + 128);
    const int tk = F.lane & 15, q = F.lane >> 4, k0 = F.wave * 128;
    for (int blk = F.vcu; blk < M / 64; blk += F.G) {
        __syncthreads();
        if (F.tid < NEXP) hist[F.tid] = 0;
        {
            bf16x8 wh[3][4], wl[3][4];
#pragma unroll
            for (int nt = 0; nt < 3; ++nt)
#pragma unroll
                for (int ks = 0; ks < 4; ++ks) { wh[nt][ks] = *(const bf16x8*)(WRH + (size_t)(nt * 16 + tk) * D + k0 + 32 * ks + 8 * q); wl[nt][ks] = *(const bf16x8*)(WRL + (size_t)(nt * 16 + tk) * D + k0 + 32 * ks + 8 * q); }
#pragma unroll
            for (int tile = 0; tile < 4; ++tile) {
                const float* hp = H + (size_t)(blk * 64 + tile * 16 + tk) * D + k0 + 8 * q;
                f32x4 acc[3]; float ss = 0.f;
#pragma unroll
                for (int nt = 0; nt < 3; ++nt) acc[nt] = (f32x4){0.f, 0.f, 0.f, 0.f};
#pragma unroll
                for (int ks = 0; ks < 4; ++ks) {
                    const f32x4 a0 = *(const f32x4*)(hp + 32 * ks), a1 = *(const f32x4*)(hp + 32 * ks + 4);
                    const float av[8] = {a0[0], a0[1], a0[2], a0[3], a1[0], a1[1], a1[2], a1[3]};
                    unsigned hh[8], ll[8];
#pragma unroll
                    for (int j = 0; j < 8; ++j) { ss += av[j] * av[j]; hh[j] = f2bf(av[j]); ll[j] = f2bf(av[j] - __builtin_bit_cast(float, hh[j] << 16)); }
                    v4u bh4, bl4;
#pragma unroll
                    for (int j = 0; j < 4; ++j) { bh4[j] = hh[2 * j] | (hh[2 * j + 1] << 16); bl4[j] = ll[2 * j] | (ll[2 * j + 1] << 16); }
                    const bf16x8 bh = __builtin_bit_cast(bf16x8, bh4), bl = __builtin_bit_cast(bf16x8, bl4);
#pragma unroll
                    for (int nt = 0; nt < 3; ++nt) {
                        acc[nt] = __builtin_amdgcn_mfma_f32_16x16x32_bf16(wh[nt][ks], bh, acc[nt], 0, 0, 0);
                        acc[nt] = __builtin_amdgcn_mfma_f32_16x16x32_bf16(wh[nt][ks], bl, acc[nt], 0, 0, 0);
                        acc[nt] = __builtin_amdgcn_mfma_f32_16x16x32_bf16(wl[nt][ks], bh, acc[nt], 0, 0, 0); }
                }
                ss += __shfl_xor(ss, 16); ss += __shfl_xor(ss, 32);
                LAS float* rp = red + ((size_t)F.wave * 64 + tile * 16 + tk) * 52;
#pragma unroll
                for (int nt = 0; nt < 3; ++nt) *(LAS f32x4*)(rp + nt * 16 + 4 * q) = acc[nt];
                if (q == 0) rp[48] = ss;
            }
        }
        __syncthreads();
        if (F.tid < 256) { const int token = F.tid >> 2, qq = F.tid & 3;
            float gl[4] = {0.f, 0.f, 0.f, 0.f}, fl[8] = {0.f, 0.f, 0.f, 0.f, 0.f, 0.f, 0.f, 0.f}; float ss = 0.f;
#pragma unroll
            for (int w = 0; w < 8; ++w) { const LAS float* rp = red + ((size_t)w * 64 + token) * 52;
                const f32x4 g4 = *(const LAS f32x4*)(rp), f0 = *(const LAS f32x4*)(rp + 16 + 4 * qq), f1 = *(const LAS f32x4*)(rp + 32 + 4 * qq);
#pragma unroll
                for (int r = 0; r < 4; ++r) { gl[r] += g4[r]; fl[r] += f0[r]; fl[4 + r] += f1[r]; }
                ss += rp[48]; }
            const float ri = 1.f / sqrtf(ss * (1.f / D) + EPS);
            if (qq == 0) rinvs[token] = ri;
            int gi = 0;
#pragma unroll
            for (int r = 0; r < 4; ++r) gl[r] = gl[r] * ri + b_grp[r];
            float gm = gl[0];
#pragma unroll
            for (int r = 1; r < 4; ++r) if (gl[r] > gm) { gm = gl[r]; gi = r; }
            float gsum = 0.f;
#pragma unroll
            for (int r = 0; r < 4; ++r) gsum += __expf(gl[r] - gm);
            const float gp = 1.0f / gsum;
#pragma unroll
            for (int r = 0; r < 8; ++r) fl[r] = fl[r] * ri + b_fine[8 * qq + r];
            int i0 = 0; float m0 = fl[0];
#pragma unroll
            for (int r = 1; r < 8; ++r) if (fl[r] > m0) { m0 = fl[r]; i0 = r; }
            int i1 = 0; float m1 = -3.0e38f;
#pragma unroll
            for (int r = 0; r < 8; ++r) if (r != i0 && fl[r] > m1) { m1 = fl[r]; i1 = r; }
            if (qq == gi) { const float e1 = __expf(m1 - m0); const float p0 = 1.0f / (1.0f + e1), p1 = e1 * p0; const int tok = blk * 64 + token;
                const int ea = gi * 8 + i0, eb = gi * 8 + i1;
                TOKE[tok * 2] = ea; TOKE[tok * 2 + 1] = eb; TOKW[tok * 2] = gp * p0; TOKW[tok * 2 + 1] = gp * p1;
                atomicAdd((int*)&hist[ea], 1); atomicAdd((int*)&hist[eb], 1); }
        }
        __syncthreads();
        if (F.tid < NEXP) HIST[blk * NEXP + F.tid] = hist[F.tid];
        {
            const f32x4 ga0 = *(const f32x4*)(g2w + 8 * F.lane), ga1 = *(const f32x4*)(g2w + 8 * F.lane + 4), gb0 = *(const f32x4*)(g2w + 512 + 8 * F.lane), gb1 = *(const f32x4*)(g2w + 512 + 8 * F.lane + 4);
#pragma unroll 4
            for (int t = 0; t < 8; ++t) { const int token = F.wave * 8 + t; const float ri = rinvs[token]; const size_t m = (size_t)blk * 64 + token;
                const float* hp = H + m * D + 8 * F.lane;
                const f32x4 a0 = *(const f32x4*)(hp), a1 = *(const f32x4*)(hp + 4), c0 = *(const f32x4*)(hp + 512), c1 = *(const f32x4*)(hp + 516);
                v4u o0, o1;
                o0.x = pk2(a0[0] * ri * ga0[0], a0[1] * ri * ga0[1]); o0.y = pk2(a0[2] * ri * ga0[2], a0[3] * ri * ga0[3]); o0.z = pk2(a1[0] * ri * ga1[0], a1[1] * ri * ga1[1]); o0.w = pk2(a1[2] * ri * ga1[2], a1[3] * ri * ga1[3]);
                o1.x = pk2(c0[0] * ri * gb0[0], c0[1] * ri * gb0[1]); o1.y = pk2(c0[2] * ri * gb0[2], c0[3] * ri * gb0[3]); o1.z = pk2(c1[0] * ri * gb1[0], c1[1] * ri * gb1[1]); o1.w = pk2(c1[2] * ri * gb1[2], c1[3] * ri * gb1[3]);
                *(GAS v4u*)(U2 + m * D + 8 * F.lane) = o0; *(GAS v4u*)(U2 + m * D + 512 + 8 * F.lane) = o1; }
        }
    }
}

__device__ __forceinline__ void p6_scatter(Frame& F) {
    unsigned char* ws = F.ws;
    const bf16* U2 = (const bf16*)(ws + WS_XN); bf16* XS = (bf16*)(ws + WS_PROJ);
    const int* TOKE = (const int*)(ws + WS_SMALL + SM_TOKE); int* TOKPOS = (int*)(ws + WS_SMALL + SM_TOKPOS); const int* HIST = (const int*)(ws + WS_SMALL + SM_HIST);
    int* TILEE = (int*)(ws + WS_SMALL + SM_TILEE);
    LAS int* ptot = (LAS int*)(F.lds); LAS int* pbel = ptot + 512; LAS int* tcnt = pbel + 512; LAS int* tbel = tcnt + 32; LAS int* off = tbel + 32; LAS int* base = off + 33; LAS int* fill = base + 32;
    for (int blk = F.vcu; blk < M / 64; blk += F.G) {
        __syncthreads();
        { const int e = F.tid & 31, part = F.tid >> 5; int tot = 0, bel = 0;
#pragma unroll 4
            for (int w = 16 * part; w < 16 * part + 16; ++w) { const int v = HIST[w * NEXP + e]; tot += v; if (w < blk) bel += v; }
            ptot[F.tid] = tot; pbel[F.tid] = bel; }
        __syncthreads();
        if (F.tid < NEXP) { int t = 0, bl = 0;
#pragma unroll
            for (int p = 0; p < 16; ++p) { t += ptot[p * 32 + F.tid]; bl += pbel[p * 32 + F.tid]; }
            tcnt[F.tid] = t; tbel[F.tid] = bl; fill[F.tid] = 0; }
        __syncthreads();
        if (F.tid == 0) { int run = 0; for (int e = 0; e < NEXP; ++e) { off[e] = run; run += (tcnt[e] + 255) & ~255; } off[NEXP] = run; }
        __syncthreads();
        if (F.tid < NEXP) base[F.tid] = off[F.tid] + tbel[F.tid];
        if (blk == 0 && F.tid < 256) { const int r0 = F.tid * 256; int e = -1;
            for (int k = 0; k < NEXP; ++k) if (off[k] <= r0 && r0 < off[k + 1]) e = k;
            TILEE[F.tid] = (F.tid == 255) ? (off[NEXP] >> 8) : (e < 0 ? 0 : e); }
        __syncthreads();
        for (int a = F.wave * 16; a < F.wave * 16 + 16; ++a) { const int tok = blk * 64 + (a >> 1), k = a & 1; const int e = TOKE[tok * 2 + k];
            int slot = 0; if (F.lane == 0) slot = atomicAdd((int*)&fill[e], 1);
            slot = __builtin_amdgcn_readfirstlane(slot); const int pos = base[e] + slot;
            if (F.lane == 0) TOKPOS[tok * 2 + k] = pos;
            const v4u* src = (const v4u*)(U2 + (size_t)tok * D); GAS v4u* dst = (GAS v4u*)(XS + (size_t)pos * D);
            dst[F.lane] = src[F.lane]; dst[64 + F.lane] = src[64 + F.lane]; }
    }
}

__device__ __forceinline__ void p9_final(Frame& F, const float* gf, float* dst) {
    unsigned char* ws = F.ws;
    const bf16* YS = (const bf16*)(ws + WS_PROJ); const float* TOKW = (const float*)(ws + WS_SMALL + SM_TOKW); const int* TOKPOS = (const int*)(ws + WS_SMALL + SM_TOKPOS);
    const int gw = F.vcu * NWAVES + F.wave, NGW = F.G * NWAVES;
    for (int m = gw; m < M; m += NGW) {
        const float w0 = TOKW[m * 2], w1 = TOKW[m * 2 + 1]; const int p0 = TOKPOS[m * 2], p1 = TOKPOS[m * 2 + 1];
        float* hrow = F.out + (size_t)m * D;
        f32x4 v[4]; float s = 0.f;
#pragma unroll
        for (int j = 0; j < 4; ++j) { v[j] = *(const f32x4*)(hrow + 4 * F.lane + 256 * j);
            const unsigned long long y0 = *(const unsigned long long*)(YS + (size_t)p0 * D + 4 * F.lane + 256 * j), y1 = *(const unsigned long long*)(YS + (size_t)p1 * D + 4 * F.lane + 256 * j);
#pragma unroll
            for (int i = 0; i < 4; ++i) { const float a = __builtin_bit_cast(float, (unsigned)((y0 >> (16 * i)) & 0xffffu) << 16), c = __builtin_bit_cast(float, (unsigned)((y1 >> (16 * i)) & 0xffffu) << 16);
                v[j][i] = v[j][i] + w0 * a + w1 * c; s += v[j][i] * v[j][i]; } }
        const float ri = 1.f / sqrtf(wave_sum(s) * (1.f / D) + EPS);
#pragma unroll
        for (int j = 0; j < 4; ++j) { const f32x4 g = *(const f32x4*)(gf + 4 * F.lane + 256 * j); *(GAS f32x4*)(dst + (size_t)m * D + 4 * F.lane + 256 * j) = v[j] * ri * g; }
    }
}
constexpr int NPHASE = 10;
struct Args { const float* in[22]; float* out; unsigned char* ws; int ph_lo, ph_hi, experts, li; };
__global__ void __launch_bounds__(NWAVES * 64, 2) mk_fwd(Args args) {
    extern __shared__ __attribute__((aligned(16))) unsigned char lds[];
    Frame F;
    F.lds = (LAS unsigned char*)lds; F.MISC = (volatile LAS unsigned*)(F.lds + MISC_OFF);
    F.tid = threadIdx.x; F.lane = F.tid & 63; F.wave = __builtin_amdgcn_readfirstlane(F.tid >> 6);
    F.G = gridDim.x; { const int bx = blockIdx.x; F.vcu = (F.G % 8 == 0) ? (bx % 8) * (F.G / 8) + bx / 8 : bx; }
    F.ws = args.ws; F.out = args.out; F.ctl = (gu32*)(args.ws + WS_CTL);
    for (int u = F.tid; u < (LDS_BYTES - LDSCTL_OFF) / 4; u += NWAVES * 64) ((LAS unsigned*)(F.lds + LDSCTL_OFF))[u] = 0u;
    __syncthreads();
    const int lo = args.ph_lo, hi = args.ph_hi;
    XcdBarrier bar; bar.bar = (unsigned*)(F.ctl + CW_BAR) + args.li * XCD_BAR_WORDS; bar.x = 0; bar.st = nullptr;
    if (hi - lo > 1) bar = xcd_barrier_post((unsigned*)(F.ctl + CW_BAR) + args.li * XCD_BAR_WORDS, F.MISC + 8);
#ifndef PH_MASK
#define PH_MASK 0x3ff
#endif
#define IN(k) (((PH_MASK >> (k)) & 1) && lo <= (k) && (k) < hi)
#define BOTH(k) (IN(k) && IN((k) + 1))
#ifndef REP_MASK
#define REP_MASK 0
#endif
#define NREP(k) (((REP_MASK >> (k)) & 1) ? 2 : 1)
#define GRID_BAR() do { xcd_barrier(bar); if ((REP_MASK >> 10) & 1) xcd_barrier(bar); } while (0)
    unsigned char* ws = args.ws;
    if (IN(0)) { for (int rep = 0; rep < NREP(0); ++rep) p0_prologue(F, args.experts != 0, args.in[0], args.in[1], args.in[2], args.in[5], args.in[7], args.in[12], args.in[13], args.in[14], args.in[16], args.in[18], args.in[19], args.in[20]); if (BOTH(0)) GRID_BAR(); }
    if (IN(1)) {
        pg8::Gemm g{(const pg8::bf16_t*)(ws + WS_XN), (const pg8::bf16_t*)(ws + WS_WIN), M, NIN, D}; pg8::StaticOrder S; S.init(M, NIN, F.G, (int)blockIdx.x);
        pg8::EpiBf16<0> E{(pg8::bf16_t*)(ws + WS_PROJ), NIN, nullptr, 512, 512, C2};
        pg8::gemm_phase<pg8::EpiBf16<0>, pg8::StaticOrder, true, true>(F.lds, g, S, E);
        if (NREP(1) == 2) pg8::gemm_phase<pg8::EpiBf16<0>, pg8::StaticOrder, true, true>(F.lds, g, S, E);
        if (BOTH(1)) GRID_BAR();
    }
    if (IN(2)) { for (int rep = 0; rep < NREP(2); ++rep) p2_mixer(F, args.in[3], args.in[4], args.in[6], args.in[8], args.in[9]); if (BOTH(2)) GRID_BAR(); }
    if (IN(3)) { for (int rep = 0; rep < NREP(3); ++rep) p3_mixnorm(F, args.in[10], args.in[11]); if (BOTH(3)) GRID_BAR(); }
    if (IN(4)) {
        pg8::Gemm g{(const pg8::bf16_t*)(ws + WS_XN), (const pg8::bf16_t*)(ws + WS_WOUT), M, D, D}; pg8::StaticOrder S; S.init(M, D, F.G, (int)blockIdx.x);
        pg8::EpiResF32 E{args.in[0], F.out, D};
        pg8::gemm_phase<pg8::EpiResF32, pg8::StaticOrder, false, true>(F.lds, g, S, E);
        if (NREP(4) == 2) pg8::gemm_phase<pg8::EpiResF32, pg8::StaticOrder, false, true>(F.lds, g, S, E);
        if (BOTH(4)) GRID_BAR();
    }
    if (IN(5)) { for (int rep = 0; rep < NREP(5); ++rep) p5_route(F, args.in[13], args.in[15], args.in[17]); if (BOTH(5)) GRID_BAR(); }
    if (IN(6)) { for (int rep = 0; rep < NREP(6); ++rep) p6_scatter(F); if (BOTH(6)) GRID_BAR(); }
    if (IN(7)) {
        LAS int* tab = (LAS int*)(F.lds + TAB_OFF);
        if (F.tid < 256) tab[F.tid] = ((const int*)(ws + WS_SMALL + SM_TILEE))[F.tid];
        __syncthreads();
        pg8::Gemm g{(const pg8::bf16_t*)(ws + WS_PROJ), (const pg8::bf16_t*)(ws + WS_WE1), XS_ROWS, NEXP * 1024, D};
        pg8::MoeOrder S{(const PG8_LAS int*)tab, tab[255] * 4, F.G, F.vcu};
        pg8::EpiGateUp E{(pg8::bf16_t*)(ws + WS_R3)};
        pg8::gemm_phase<pg8::EpiGateUp, pg8::MoeOrder, true, true>(F.lds, g, S, E);
        if (NREP(7) == 2) pg8::gemm_phase<pg8::EpiGateUp, pg8::MoeOrder, true, true>(F.lds, g, S, E);
        if (BOTH(7)) GRID_BAR();
    }
    if (IN(8)) {
        LAS int* tab = (LAS int*)(F.lds + TAB_OFF);
        if (F.tid < 256) tab[F.tid] = ((const int*)(ws + WS_SMALL + SM_TILEE))[F.tid];
        __syncthreads();
        pg8::Gemm g{(const pg8::bf16_t*)(ws + WS_R3), (const pg8::bf16_t*)(ws + WS_WE2), XS_ROWS, NEXP * 1024, DEXP};
        pg8::MoeOrder S{(const PG8_LAS int*)tab, tab[255] * 4, F.G, F.vcu};
        pg8::EpiBf16<0> E{(pg8::bf16_t*)(ws + WS_PROJ), D, nullptr, 1024, 0, 1.0f};
        pg8::gemm_phase<pg8::EpiBf16<0>, pg8::MoeOrder, true, true>(F.lds, g, S, E);
        if (NREP(8) == 2) pg8::gemm_phase<pg8::EpiBf16<0>, pg8::MoeOrder, true, true>(F.lds, g, S, E);
        if (BOTH(8)) GRID_BAR();
    }
    if (IN(9)) { if (NREP(9) == 2) p9_final(F, args.in[21], (float*)(ws + WS_WE1)); p9_final(F, args.in[21], F.out); }
#undef IN
#undef BOTH
#undef GRID_BAR
}
#ifndef HYB
#define HYB 4
#endif
#ifndef SPLIT_LAUNCH
#define SPLIT_LAUNCH 0
#endif
static void launch_fast(const Args& base, int lo, int hi, int grid, hipStream_t stream) {
    if (SPLIT_LAUNCH) { for (int p = lo; p < hi; ++p) { Args a = base; a.ph_lo = p; a.ph_hi = p + 1; a.li = 0; hipLaunchKernelGGL(mk_fwd, dim3(grid), dim3(NWAVES * 64), LDS_BYTES, stream, a); } }
    else { Args a = base; a.ph_lo = lo; a.ph_hi = hi; a.li = 0; hipLaunchKernelGGL(mk_fwd, dim3(grid), dim3(NWAVES * 64), LDS_BYTES, stream, a); }
    const hipError_t le = hipPeekAtLastError();
    if (le != hipSuccess) fprintf(stderr, "kernel_launch: launch failed: %s\n", hipGetErrorName(le));
}
extern "C" void kernel_launch(void* const* d_in, const int* in_sizes, int n_in, void* d_out, int out_size, void* d_ws, size_t ws_size, hipStream_t stream) {
    static int grid = 0;
    if (grid == 0) {
        if (n_in != 22 || out_size != M * D || ws_size < 266 * MiB) { fprintf(stderr, "kernel_launch: unexpected shapes (n_in %d out %d ws %zu); nothing launched\n", n_in, out_size, ws_size); grid = -1; return; }
        int dev = 0, cus = 0, per_cu = 0;
        if (hipGetDevice(&dev) != hipSuccess || hipDeviceGetAttribute(&cus, hipDeviceAttributeMultiprocessorCount, dev) != hipSuccess) { grid = -1; return; }
        if (hipFuncSetAttribute((const void*)mk_fwd, hipFuncAttributeMaxDynamicSharedMemorySize, LDS_BYTES) != hipSuccess) { fprintf(stderr, "kernel_launch: hipFuncSetAttribute failed\n"); grid = -1; return; }
        if (hipOccupancyMaxActiveBlocksPerMultiprocessor(&per_cu, (const void*)mk_fwd, NWAVES * 64, LDS_BYTES) != hipSuccess || per_cu < 1)
            fprintf(stderr, "kernel_launch: note: occupancy query reports %d workgroups per CU\n", per_cu);
        (void)hipGetLastError();
        grid = cus;
    }
    if (grid < 0) return;
    (void)hipMemsetAsync((char*)d_ws + WS_CTL, 0, CTL_ZERO_BYTES, stream);
    Args a{};
    for (int i = 0; i < 22; ++i) a.in[i] = (const float*)d_in[i];
    a.out = (float*)d_out; a.ws = (unsigned char*)d_ws; a.experts = 1; a.li = 0;
#if HYB >= 4
    launch_fast(a, 0, NPHASE, grid, stream);
#ifdef TWICE
    { Args a2 = a; a2.ph_lo = 0; a2.ph_hi = NPHASE; a2.li = 1; hipLaunchKernelGGL(mk_fwd, dim3(grid), dim3(NWAVES * 64), LDS_BYTES, stream, a2); }
#endif
#else
    using namespace nv;
    const float* x = a.in[0];
    char* ws = (char*)d_ws; float* out = (float*)d_out;
    float* RA = (float*)(ws + 1 * MiB); float* XC = (float*)(ws + 65 * MiB); float* AA = out; float* UU = out + (size_t)NM * 512;
    float* ACT = (float*)(ws + 65 * MiB); float* Y = (float*)(ws + 129 * MiB);
    int* cnt = (int*)(ws + 262 * MiB); int* eid = (int*)(ws + 262 * MiB + 4096); float* ew = (float*)(ws + 262 * MiB + 4096 + NM * 8); int* list = (int*)(ws + 263 * MiB);
    (void)hipMemsetAsync(cnt, 0, 4096, stream);
    const unsigned short* PROJB = (const unsigned short*)(ws + WS_PROJ);
#if HYB == 1
    launch_fast(a, 0, 2, grid, stream);
    k_attn<unsigned short, true><<<dim3(NS / 256, 8, NB), 256, 0, stream>>>(PROJB, RA, ND);
    k_conv<unsigned short><<<NM * 512 / 256, 256, 0, stream>>>(PROJB, a.in[3], a.in[4], XC);
    k_gate<<<NM * 512 / 256, 256, 0, stream>>>(XC, a.in[5], a.in[6], a.in[7], a.in[8], a.in[9], AA, UU);
    k_scan<unsigned short><<<16, 64, 0, stream>>>(AA, UU, PROJB, RA, ND);
    k_rms<8><<<2048, 256, 0, stream>>>(RA, ND, a.in[10], RA, ND, NM);
    k_rms<8><<<2048, 256, 0, stream>>>(RA + 512, ND, a.in[11], RA + 512, ND, NM);
    { SgP p{}; p.A = RA; p.lda = ND; p.B = a.in[12]; p.ldb = ND; p.C = out; p.ldc = ND; p.R = x; p.M = NM; p.N = ND; p.K = ND;
      k_sgemm<false, float><<<dim3(ND / 64, NM / 64, 1), 256, 0, stream>>>(p); }
#elif HYB == 2
    launch_fast(a, 0, 4, grid, stream);
    { SgP p{}; p.A = ws + WS_XN; p.lda = ND; p.B = a.in[12]; p.ldb = ND; p.C = out; p.ldc = ND; p.R = x; p.M = NM; p.N = ND; p.K = ND;
      k_sgemm<false, unsigned short><<<dim3(ND / 64, NM / 64, 1), 256, 0, stream>>>(p); }
#elif HYB == 3
    launch_fast(a, 0, 5, grid, stream);
#endif
    k_route<<<2048, 256, 0, stream>>>(out, a.in[13], a.in[14], a.in[15], a.in[16], a.in[17], RA, eid, ew, cnt, list);
    { SgP p{}; p.A = RA; p.lda = ND; p.B = a.in[18]; p.B2 = a.in[19]; p.ldb = NDE; p.C = ACT; p.ldc = NDE; p.M = NM; p.N = NDE; p.K = ND;
      p.list = list; p.cnt = cnt; p.lstride = NM; p.bstride = (long)ND * NDE; p.ashift = 1;
      k_sgemm<true, float><<<dim3(NDE / 64, NM / 64, NE), 256, 0, stream>>>(p); }
    { SgP p{}; p.A = ACT; p.lda = NDE; p.B = a.in[20]; p.ldb = ND; p.C = Y; p.ldc = ND; p.M = NM; p.N = ND; p.K = NDE;
      p.list = list; p.cnt = cnt; p.lstride = NM; p.bstride = (long)NDE * ND; p.ashift = 0;
      k_sgemm<false, float><<<dim3(ND / 64, NM / 64, NE), 256, 0, stream>>>(p); }
    k_final<<<2048, 256, 0, stream>>>(out, Y, ew, a.in[21], out);
#endif
}
```
